# Optimizing an MI355X kernel written in HIP

```python
import math
import jax
import jax.numpy as jnp
from jax import lax
import numpy as np


D_MODEL = 1024
BATCH = 4
SEQ = 4096
DEPTH = 2

CHUNK = 64
Q_BLOCK = 128
N_BRANCH = 4
BRANCH_WIDTH = D_MODEL // N_BRANCH
HEAD_DIM = 64
N_HEADS = BRANCH_WIDTH // HEAD_DIM
IDX_HEADS = 4
IDX_DIM = 32
TOPK_MAX = 256
RET_DECAY_BASE = 5.0
S5_GROUP = 16
S5_GROUPS = BRANCH_WIDTH // S5_GROUP
S5_STATE = 64
S5_DT_MIN = 1e-3
S5_DT_MAX = 1e-1
MLA_Q_RANK = D_MODEL // 4
MLA_KV_RANK = D_MODEL // 8
MLA_NOPE = 64
MLA_ROPE = 32
MLA_V = 64
ROPE_THETA = 10000.0
D_FF = 2816
LN_EPS = 1e-5
RMS_EPS = 1e-6
DN_ALPHA = (2 * DEPTH) ** 0.25
DN_BETA = (8 * DEPTH) ** -0.25

IN_WIDTHS = (
    N_HEADS * HEAD_DIM,
    HEAD_DIM,
    HEAD_DIM,
    IDX_HEADS * IDX_DIM,
    IDX_DIM,
    IDX_HEADS,
    BRANCH_WIDTH,
    BRANCH_WIDTH,
    BRANCH_WIDTH,
    BRANCH_WIDTH,
    BRANCH_WIDTH,
    MLA_Q_RANK,
    MLA_KV_RANK,
    MLA_ROPE,
    N_BRANCH * D_MODEL,
)
N_IN = sum(IN_WIDTHS)
IN_SPLITS = tuple(int(v) for v in np.cumsum(IN_WIDTHS)[:-1])

kernel_name = 'hybrid_chunk_causal_dsa_retention_s5_mla_block'


def _layer_norm(x, g, b):
    xf = x.astype(jnp.float32)
    mu = jnp.mean(xf, axis=-1, keepdims=True)
    var = jnp.mean(jnp.square(xf - mu), axis=-1, keepdims=True)
    return (xf - mu) * lax.rsqrt(var + LN_EPS) * g + b


def _rms_norm(x, g):
    xf = x.astype(jnp.float32)
    return xf * lax.rsqrt(jnp.mean(jnp.square(xf), axis=-1, keepdims=True) + RMS_EPS) * g


def _swiglu(x, wi, wo):
    a, b = jnp.split(x @ wi, 2, axis=-1)
    return (jax.nn.silu(a) * b) @ wo


def _chunk_limit(pos):
    return (pos // CHUNK + 1) * CHUNK


def _alibi_slopes(h):
    return jnp.exp2(-8.0 * jnp.arange(1, h + 1, dtype=jnp.float32) / h)


def _rope(x, pos):
    half = x.shape[-1] // 2
    freqs = ROPE_THETA ** (-jnp.arange(half, dtype=jnp.float32) / half)
    ang = pos[:, None] * freqs[None, :]
    cos = jnp.cos(ang)[:, None, :]
    sin = jnp.sin(ang)[:, None, :]
    x1, x2 = x[..., :half], x[..., half:]
    return jnp.concatenate([x1 * cos - x2 * sin, x1 * sin + x2 * cos], axis=-1)


def _to_blocks(a):
    b, s = a.shape[:2]
    return jnp.moveaxis(a.reshape((b, s // Q_BLOCK, Q_BLOCK) + a.shape[2:]), 1, 0)


def _from_blocks(a):
    nb, b, qb = a.shape[:3]
    return jnp.moveaxis(a, 0, 1).reshape((b, nb * qb) + a.shape[3:])


def _dsa(q, k, v, iq, ik, iw):
    s_len = q.shape[1]
    topk = min(TOPK_MAX, s_len // 4)
    key_pos = jnp.arange(s_len, dtype=jnp.int32)
    slopes = _alibi_slopes(N_HEADS)
    scale = HEAD_DIM ** -0.5
    iw = iw.astype(jnp.float32) * (IDX_HEADS ** -0.5 * IDX_DIM ** -0.5)
    gather = jax.vmap(lambda tab, ix: tab[ix])

    def block(args):
        qb, iqb, iwb, blk = args
        qpos = blk * Q_BLOCK + jnp.arange(Q_BLOCK, dtype=jnp.int32)
        limit = _chunk_limit(qpos)
        admissible = key_pos[None, :] < limit[:, None]
        rel = jax.nn.relu(jnp.einsum('bqhc,bsc->bqhs', iqb, ik).astype(jnp.float32))
        iscore = jnp.einsum('bqhs,bqh->bqs', rel, iwb)
        iscore = jnp.where(admissible[None], iscore, -jnp.inf)
        _, idx = lax.top_k(iscore, topk)
        k_sel = gather(k, idx)
        v_sel = gather(v, idx)
        logits = jnp.einsum('bqhd,bqkd->bhqk', qb, k_sel).astype(jnp.float32) * scale
        dist = jnp.abs(qpos[None, :, None] - idx).astype(jnp.float32)
        logits = logits - slopes[None, :, None, None] * dist[:, None]
        valid = idx < limit[None, :, None]
        logits = jnp.where(valid[:, None], logits, -jnp.inf)
        p = jax.nn.softmax(logits, axis=-1)
        return jnp.einsum('bhqk,bqkd->bqhd', p.astype(v_sel.dtype), v_sel)

    nb = s_len // Q_BLOCK
    out = lax.map(block, (_to_blocks(q), _to_blocks(iq), _to_blocks(iw), jnp.arange(nb, dtype=jnp.int32)))
    return _from_blocks(out)


def _retention(q, k, v, g, gn_w):
    b, s_len, h, dk = q.shape
    dv = v.shape[-1]
    nc = s_len // CHUNK
    log_g = jnp.log1p(-jnp.exp2(-RET_DECAY_BASE - jnp.arange(h, dtype=jnp.float32)))
    n = jnp.arange(CHUNK, dtype=jnp.float32)
    decay_intra = jnp.exp(log_g[:, None, None] * jnp.abs(n[:, None] - n[None, :]))
    xi = jnp.exp(log_g[:, None] * (n + 1.0))
    zeta = jnp.exp(log_g[:, None] * (CHUNK - 1.0 - n))
    g_chunk = jnp.exp(log_g * CHUNK)

    def chunked(a):
        return a.reshape(b, nc, CHUNK, h, -1).transpose(0, 3, 1, 2, 4).astype(jnp.float32)

    qc = chunked(q)
    kc = chunked(k) * (dk ** -0.5)
    vc = chunked(v)
    scores = jnp.einsum('bhjnd,bhjmd->bhjnm', qc, kc) * decay_intra[:, None]
    intra = jnp.einsum('bhjnm,bhjme->bhjne', scores, vc)
    kv = jnp.einsum('bhjmd,bhjme->bhjde', kc * zeta[:, None, :, None], vc)

    def step(state, kv_j):
        return g_chunk[None, :, None, None] * state + kv_j, state

    _, prev = lax.scan(step, jnp.zeros((b, h, dk, dv), jnp.float32), jnp.moveaxis(kv, 2, 0))
    prev = jnp.moveaxis(prev, 0, 2)
    inter = jnp.einsum('bhjnd,bhjde->bhjne', qc * xi[:, None, :, None], prev)
    ret = (intra + inter).transpose(0, 2, 3, 1, 4).reshape(b, s_len, h, dv)
    mu = jnp.mean(ret, axis=-1, keepdims=True)
    var = jnp.mean(jnp.square(ret - mu), axis=-1, keepdims=True)
    ret = ((ret - mu) * lax.rsqrt(var + LN_EPS)).reshape(b, s_len, h * dv) * gn_w
    return jax.nn.silu(g.astype(jnp.float32)) * ret


def _s5(u, a_re, a_im, b_re, b_im, c_re, c_im, d, log_step, w_glu):
    b, s_len = u.shape[:2]
    uf = u.astype(jnp.float32).reshape(b, s_len, S5_GROUPS, S5_GROUP)
    a = lax.complex(a_re.astype(jnp.float32), a_im.astype(jnp.float32))
    dt = jnp.exp(log_step.astype(jnp.float32))[:, None]
    a_bar = jnp.exp(a * dt)
    b_mat = lax.complex(b_re.astype(jnp.float32), b_im.astype(jnp.float32))
    b_bar = ((a_bar - 1.0) / a)[..., None] * b_mat
    bu = jnp.einsum('bsgc,gpc->bsgp', uf.astype(jnp.complex64), b_bar)
    a_seq = jnp.broadcast_to(a_bar, bu.shape)

    def combine(e1, e2):
        a1, x1 = e1
        a2, x2 = e2
        return a2 * a1, a2 * x1 + x2

    _, states = lax.associative_scan(combine, (a_seq, bu), axis=1)
    c_mat = lax.complex(c_re.astype(jnp.float32), c_im.astype(jnp.float32))
    y = jnp.einsum('bsgp,gcp->bsgc', states, c_mat).real + d.astype(jnp.float32) * uf
    y = jax.nn.gelu(y.reshape(b, s_len, BRANCH_WIDTH))
    val, gate = jnp.split(y @ w_glu, 2, axis=-1)
    return val * jax.nn.sigmoid(gate)


def _mla(cq, ckv, kr, q_norm, kv_norm, w_uq, w_ukv):
    b, s_len = cq.shape[:2]
    pos = jnp.arange(s_len, dtype=jnp.float32)
    q = (_rms_norm(cq, q_norm) @ w_uq).reshape(b, s_len, N_HEADS, MLA_NOPE + MLA_ROPE)
    kv = (_rms_norm(ckv, kv_norm) @ w_ukv).reshape(b, s_len, N_HEADS, MLA_NOPE + MLA_V)
    k_nope, v = kv[..., :MLA_NOPE], kv[..., MLA_NOPE:]
    k_rope = _rope(kr[:, :, None, :].astype(jnp.float32), pos)
    q = jnp.concatenate([q[..., :MLA_NOPE], _rope(q[..., MLA_NOPE:], pos)], axis=-1)
    k = jnp.concatenate([k_nope, jnp.broadcast_to(k_rope, (b, s_len, N_HEADS, MLA_ROPE))], axis=-1)
    scale = (MLA_NOPE + MLA_ROPE) ** -0.5
    key_pos = jnp.arange(s_len, dtype=jnp.int32)

    def block(args):
        qb, blk = args
        qpos = blk * Q_BLOCK + jnp.arange(Q_BLOCK, dtype=jnp.int32)
        mask = key_pos[None, :] < _chunk_limit(qpos)[:, None]
        sc = jnp.einsum('bqhd,bkhd->bhqk', qb, k).astype(jnp.float32) * scale
        p = jax.nn.softmax(jnp.where(mask[None, None], sc, -jnp.inf), axis=-1)
        return jnp.einsum('bhqk,bkhd->bqhd', p.astype(v.dtype), v)

    nb = s_len // Q_BLOCK
    out = lax.map(block, (_to_blocks(q), jnp.arange(nb, dtype=jnp.int32)))
    return _from_blocks(out).reshape(b, s_len, N_HEADS * MLA_V)


def _mixer(x, w_in, ret_gn, s5_a_re, s5_a_im, s5_b_re, s5_b_im, s5_c_re, s5_c_im, s5_d,
           s5_log_step, s5_w_glu, mla_q_norm, mla_kv_norm, mla_w_uq, mla_w_ukv, w_branch, w_out):
    b, s_len, _ = x.shape
    h = x @ w_in
    (dq, dk, dv, iq, ik, iw, rq, rk, rv, rg, su, cq, ckv, kr, gates) = jnp.split(h, IN_SPLITS, axis=-1)
    o_a = _dsa(dq.reshape(b, s_len, N_HEADS, HEAD_DIM), dk, dv,
               iq.reshape(b, s_len, IDX_HEADS, IDX_DIM), ik, iw).reshape(b, s_len, BRANCH_WIDTH)
    o_b = _retention(rq.reshape(b, s_len, N_HEADS, HEAD_DIM), rk.reshape(b, s_len, N_HEADS, HEAD_DIM),
                     rv.reshape(b, s_len, N_HEADS, HEAD_DIM), rg, ret_gn)
    o_c = _s5(su, s5_a_re, s5_a_im, s5_b_re, s5_b_im, s5_c_re, s5_c_im, s5_d, s5_log_step, s5_w_glu)
    o_d = _mla(cq, ckv, kr, mla_q_norm, mla_kv_norm, mla_w_uq, mla_w_ukv)
    branches = jnp.stack([o_a.astype(jnp.float32), o_b.astype(jnp.float32),
                          o_c.astype(jnp.float32), o_d.astype(jnp.float32)], axis=2)
    up = jnp.einsum('bsnc,ncd->bsnd', branches, w_branch)
    gate = jax.nn.sigmoid(gates.reshape(b, s_len, N_BRANCH, D_MODEL).astype(jnp.float32))
    merged = jnp.sum(gate * up, axis=2)
    return merged @ w_out


def setup_inputs(seed: int = 0) -> dict:
    key = jax.random.key(seed)
    ks = jax.random.split(key, 22)
    nrm = jax.random.normal
    f32 = jnp.float32
    x = nrm(ks[0], (BATCH, SEQ, D_MODEL), f32)
    ln_g = 1.0 + 0.02 * nrm(ks[1], (DEPTH, 3, D_MODEL), f32)
    ln_b = 0.02 * nrm(ks[2], (DEPTH, 3, D_MODEL), f32)
    ffn_wi = nrm(ks[3], (DEPTH, 2, D_MODEL, 2 * D_FF), f32) * (D_MODEL ** -0.5 * DN_BETA)
    ffn_wo = nrm(ks[4], (DEPTH, 2, D_FF, D_MODEL), f32) * (D_FF ** -0.5 * DN_BETA)
    w_in = nrm(ks[5], (DEPTH, D_MODEL, N_IN), f32) * D_MODEL ** -0.5
    ret_gn = 1.0 + 0.02 * nrm(ks[6], (DEPTH, BRANCH_WIDTH), f32)
    s5_a_re = -0.5 * jnp.exp(0.02 * nrm(ks[7], (DEPTH, S5_GROUPS, S5_STATE), f32))
    s5_a_im = math.pi * jnp.arange(S5_STATE, dtype=f32) + 0.02 * nrm(ks[8], (DEPTH, S5_GROUPS, S5_STATE), f32)
    s5_b_re = nrm(ks[9], (DEPTH, S5_GROUPS, S5_STATE, S5_GROUP), f32) * (2 * S5_GROUP) ** -0.5
    s5_b_im = nrm(ks[10], (DEPTH, S5_GROUPS, S5_STATE, S5_GROUP), f32) * (2 * S5_GROUP) ** -0.5
    s5_c_re = nrm(ks[11], (DEPTH, S5_GROUPS, S5_GROUP, S5_STATE), f32) * (2 * S5_STATE) ** -0.5
    s5_c_im = nrm(ks[12], (DEPTH, S5_GROUPS, S5_GROUP, S5_STATE), f32) * (2 * S5_STATE) ** -0.5
    s5_d = nrm(ks[13], (DEPTH, S5_GROUPS, S5_GROUP), f32)
    s5_log_step = jax.random.uniform(ks[14], (DEPTH, S5_GROUPS), f32,
                                     minval=math.log(S5_DT_MIN), maxval=math.log(S5_DT_MAX))
    s5_w_glu = nrm(ks[15], (DEPTH, BRANCH_WIDTH, 2 * BRANCH_WIDTH), f32) * BRANCH_WIDTH ** -0.5
    mla_q_norm = 1.0 + 0.02 * nrm(ks[16], (DEPTH, MLA_Q_RANK), f32)
    mla_kv_norm = 1.0 + 0.02 * nrm(ks[17], (DEPTH, MLA_KV_RANK), f32)
    mla_w_uq = nrm(ks[18], (DEPTH, MLA_Q_RANK, N_HEADS * (MLA_NOPE + MLA_ROPE)), f32) * MLA_Q_RANK ** -0.5
    mla_w_ukv = nrm(ks[19], (DEPTH, MLA_KV_RANK, N_HEADS * (MLA_NOPE + MLA_V)), f32) * MLA_KV_RANK ** -0.5
    w_branch = nrm(ks[20], (DEPTH, N_BRANCH, BRANCH_WIDTH, D_MODEL), f32) * (BRANCH_WIDTH ** -0.5 * DN_BETA)
    w_out = nrm(ks[21], (DEPTH, D_MODEL, D_MODEL), f32) * (D_MODEL ** -0.5 * DN_BETA)
    return {'x': x, 'ln_g': ln_g, 'ln_b': ln_b, 'ffn_wi': ffn_wi, 'ffn_wo': ffn_wo, 'w_in': w_in,
            'ret_gn': ret_gn, 's5_a_re': s5_a_re, 's5_a_im': s5_a_im, 's5_b_re': s5_b_re,
            's5_b_im': s5_b_im, 's5_c_re': s5_c_re, 's5_c_im': s5_c_im, 's5_d': s5_d,
            's5_log_step': s5_log_step, 's5_w_glu': s5_w_glu, 'mla_q_norm': mla_q_norm,
            'mla_kv_norm': mla_kv_norm, 'mla_w_uq': mla_w_uq, 'mla_w_ukv': mla_w_ukv,
            'w_branch': w_branch, 'w_out': w_out}


def reference(x, ln_g, ln_b, ffn_wi, ffn_wo, w_in, ret_gn, s5_a_re, s5_a_im, s5_b_re, s5_b_im,
              s5_c_re, s5_c_im, s5_d, s5_log_step, s5_w_glu, mla_q_norm, mla_kv_norm, mla_w_uq,
              mla_w_ukv, w_branch, w_out):
    out_dtype = x.dtype
    for l in range(DEPTH):
        x = _layer_norm(DN_ALPHA * x + 0.5 * _swiglu(x, ffn_wi[l, 0], ffn_wo[l, 0]), ln_g[l, 0], ln_b[l, 0])
        mix = _mixer(x, w_in[l], ret_gn[l], s5_a_re[l], s5_a_im[l], s5_b_re[l], s5_b_im[l],
                     s5_c_re[l], s5_c_im[l], s5_d[l], s5_log_step[l], s5_w_glu[l], mla_q_norm[l],
                     mla_kv_norm[l], mla_w_uq[l], mla_w_ukv[l], w_branch[l], w_out[l])
        x = _layer_norm(DN_ALPHA * x + mix, ln_g[l, 1], ln_b[l, 1])
        x = _layer_norm(DN_ALPHA * x + 0.5 * _swiglu(x, ffn_wi[l, 1], ffn_wo[l, 1]), ln_g[l, 2], ln_b[l, 2])
    return x.astype(out_dtype)
```

```cpp
#include <hip/hip_cooperative_groups.h>
#include <hip/hip_runtime.h>
#include <cstdio>
#include <cstdint>
namespace pg8 {
#define PG8_LAS __attribute__((address_space(3)))
typedef unsigned short bf16_t;
typedef short bf16x8 __attribute__((ext_vector_type(8)));
typedef float f32x4 __attribute__((ext_vector_type(4)));
typedef unsigned u32x4 __attribute__((ext_vector_type(4)));
constexpr int BM = 256, BK = 64, HALF = 128, HTB = HALF * BK * 2  , STAGE_BYTES = 8 * HTB, NXCD = 8, WGM = 8;

__host__ __device__ __forceinline__ int lds_byte(int r, int c) { const int st = (r >> 4) * 2 + (c >> 5), rr = r & 15, cc = c & 31, ob = rr * 64 + cc * 2; return st * 1024 + (ob ^ (((ob >> 9) & 1) << 5)); }
__host__ __device__ __forceinline__ void stage_rc(int b, int& R, int& C) { const int st = b / 1024, sb = b % 1024, swz = sb ^ (((sb >> 9) & 1) << 5); R = (st >> 1) * 16 + swz / 64; C = (st & 1) * 32 + (swz % 64) / 2; }
__host__ __device__ __forceinline__ int perm32(int rho) { const int n = rho >> 4, i = rho & 15; return 8 * (i >> 2) + 4 * n + (i & 3); }

struct Unit { int pm, pn; };
struct Gemm { const bf16_t* A; const bf16_t* Bt; int M, N, K; };

struct StaticOrder {
    int nM, nN, nwg, G, c;
    __host__ __device__ void init(int M, int N, int G_, int c_) { nM = M / BM; nN = N / BM; nwg = nM * nN; G = G_; c = c_; }
    __host__ __device__ bool next(int i, Unit& u) const {
        const long L = (long)i * G + c; if (L >= nwg) return false;
        int wgid = (int)L; { const int q = nwg / NXCD, r = nwg % NXCD, xcd = wgid % NXCD, off = wgid / NXCD; wgid = (xcd < r ? xcd * (q + 1) : r * (q + 1) + (xcd - r) * q) + off; }
        const int nig = WGM * nN, gid = wgid / nig, fm = gid * WGM, gsz = (nM - fm) < WGM ? (nM - fm) : WGM;
        u.pm = fm + ((wgid % nig) % gsz); u.pn = (wgid % nig) / gsz; return true;
    }
    __device__ __forceinline__ void a_ready(const Unit&) const {}
    __device__ __forceinline__ void done(const Unit&) const {}
};

typedef float f32x2c_t __attribute__((ext_vector_type(2))); typedef __bf16 bf16x2c_t __attribute__((ext_vector_type(2)));
__device__ __forceinline__ unsigned cvt_pk_bf16(float lo, float hi) { f32x2c_t v = {lo, hi}; bf16x2c_t b = __builtin_convertvector(v, bf16x2c_t); return __builtin_bit_cast(unsigned, b); }
typedef float f32x2 __attribute__((ext_vector_type(2)));
__device__ __forceinline__ f32x2 gelu_pk(f32x2 v) {
    const f32x2 av = __builtin_elementwise_abs(v), d = av * 0.2316418882f + 1.0f;
    f32x2 t; t.x = __builtin_amdgcn_rcpf(d.x); t.y = __builtin_amdgcn_rcpf(d.y);
    f32x2 q = t * 0.5307027145f + (-0.7265760135f); q = q * t + 0.7107068705f; q = q * t + (-0.142248368f); q = q * t + 0.127414796f; q = q * t;
    const f32x2 s = (v * v) * (-0.72134752044f);
    f32x2 e; e.x = __builtin_amdgcn_exp2f(s.x); e.y = __builtin_amdgcn_exp2f(s.y);
    const f32x2 m = v * (q * e), r = v - m;
    f32x2 o; o.x = v.x < 0.f ? m.x : r.x; o.y = v.y < 0.f ? m.y : r.y; return o;
}

template <int ACT  > struct EpiBf16 {
    static constexpr bool PERM = true, AFTER_DRAIN = false; static_assert(ACT == 0 || ACT == 1, "EpiBf16: ACT is 0 (none) or 1 (gelu_pk)");
    bf16_t* O; int ldc; const float* bias; int split_cols; size_t split_stride; float scale0;
    __device__ __forceinline__ void operator()(const f32x4 (&acc)[2][2][4][2], const Unit& u, int wr, int wc, int fr, int fq) const {
        const int row0 = u.pm * BM + wr * 64 + fr; int colt = u.pn * BM; bf16_t* base = O;
        float sc = 1.f; if (split_cols) { const int t = colt / split_cols; base += (size_t)t * split_stride; colt -= t * split_cols; if (t == 0) sc = scale0; }
        const int col0 = colt + wc * 32 + 8 * fq, bcol0 = u.pn * BM + wc * 32 + 8 * fq;
        f32x4 bv[2][2];
#pragma unroll
        for (int bj = 0; bj < 2; ++bj)
#pragma unroll
            for (int n = 0; n < 2; ++n) bv[bj][n] = bias ? *(const f32x4*)(bias + bcol0 + bj * HALF + 4 * n) : (f32x4){0.f, 0.f, 0.f, 0.f};
#pragma unroll
        for (int ai = 0; ai < 2; ++ai)
#pragma unroll
            for (int m = 0; m < 4; ++m) { bf16_t* rowp = base + (size_t)(row0 + ai * HALF + m * 16) * ldc + col0;
#pragma unroll
                for (int bj = 0; bj < 2; ++bj) { f32x4 v0 = acc[ai][bj][m][0] + bv[bj][0], v1 = acc[ai][bj][m][1] + bv[bj][1];
                    if (ACT == 1) { f32x2 a = gelu_pk((f32x2){v0[0], v0[1]}), b = gelu_pk((f32x2){v0[2], v0[3]}), c = gelu_pk((f32x2){v1[0], v1[1]}), d = gelu_pk((f32x2){v1[2], v1[3]});
                        v0 = (f32x4){a.x, a.y, b.x, b.y}; v1 = (f32x4){c.x, c.y, d.x, d.y}; }
                    v0 = v0 * sc; v1 = v1 * sc; u32x4 w; w.x = cvt_pk_bf16(v0[0], v0[1]); w.y = cvt_pk_bf16(v0[2], v0[3]); w.z = cvt_pk_bf16(v1[0], v1[1]); w.w = cvt_pk_bf16(v1[2], v1[3]);
                    *(u32x4*)(rowp + bj * HALF) = w; } }
    }
};

struct PanelStats {
    unsigned* xbuf;
    unsigned* cnt;
    unsigned* tmo;
    int ntn; float eps;
    unsigned code;
    __device__ __forceinline__ bool run(const f32x4 (&v)[2][2][4][2], const Unit& u, int wr, int wc, int fr, int fq, PG8_LAS unsigned char* lds, int wid, int lane) const {
        typedef float f32x2v __attribute__((ext_vector_type(2)));
        PG8_LAS f32x2v* P = (PG8_LAS f32x2v*)lds;
        PG8_LAS f32x2v* S = (PG8_LAS f32x2v*)(lds + 8192);
        PG8_LAS unsigned* flag = (PG8_LAS unsigned*)(lds + 8192 + 2048);
#pragma unroll
        for (int ai = 0; ai < 2; ++ai)
#pragma unroll
            for (int m = 0; m < 4; ++m) {
                float s = 0.f;
#pragma unroll
                for (int bj = 0; bj < 2; ++bj)
#pragma unroll
                    for (int n = 0; n < 2; ++n) { const f32x4 x = v[ai][bj][m][n]; s += (x[0] + x[1]) + (x[2] + x[3]); }
                s += __shfl_xor(s, 16); s += __shfl_xor(s, 32);
                const float mw = s * (1.0f / 64.0f); float q = 0.f;
#pragma unroll
                for (int bj = 0; bj < 2; ++bj)
#pragma unroll
                    for (int n = 0; n < 2; ++n) { const f32x4 d = v[ai][bj][m][n] - mw; q += (d[0] * d[0] + d[1] * d[1]) + (d[2] * d[2] + d[3] * d[3]); }
                q += __shfl_xor(q, 16); q += __shfl_xor(q, 32);
                if (fq == 0) P[(ai * HALF + wr * 64 + m * 16 + fr) * 4 + wc] = (f32x2v){mw, q};
            }
        asm volatile("s_waitcnt lgkmcnt(0)" ::: "memory"); __builtin_amdgcn_s_barrier(); asm volatile("" ::: "memory");
#if defined(BROKEN_EXCHANGE_NO_WAIT)
#warning BROKEN CONTROL BUILD: the row-statistics exchange does not wait; results are wrong by design
        if (blockIdx.x >= 64) { const long long t0_ = clock64(); while (clock64() - t0_ < 60000) __builtin_amdgcn_s_sleep(8); }
#endif
        const int row = wid * 32 + (lane & 31);
        if (lane < 32) {
            const f32x2v a = P[row * 4 + 0], b = P[row * 4 + 1], c = P[row * 4 + 2], d = P[row * 4 + 3];
            const float mt = (a.x + b.x + c.x + d.x) * 0.25f;
            const float da = a.x - mt, db = b.x - mt, dc = c.x - mt, dd = d.x - mt;
            const float m2 = (a.y + b.y) + (c.y + d.y) + 64.0f * ((da * da + db * db) + (dc * dc + dd * dd));
            unsigned long long* slot = (unsigned long long*)xbuf + ((size_t)(u.pm * BM + row) * 4 + u.pn);
            __hip_atomic_store(slot, ((unsigned long long)__float_as_uint(m2) << 32) | __float_as_uint(mt), __ATOMIC_RELAXED, __HIP_MEMORY_SCOPE_AGENT);
        }
        asm volatile("s_waitcnt vmcnt(0)" ::: "memory");
        if (lane == 0) __hip_atomic_fetch_add(cnt + 64 * u.pm, 1u, __ATOMIC_RELAXED, __HIP_MEMORY_SCOPE_AGENT);
        if (wid == 0) {
            bool dead = false; const unsigned long long t0 = __builtin_amdgcn_s_memrealtime(); const unsigned want = 8u * (unsigned)ntn;
            for (;;) {
#if defined(BROKEN_EXCHANGE_NO_WAIT)
                break;
#endif
                if ((unsigned)__builtin_amdgcn_readfirstlane(__hip_atomic_load(cnt + 64 * u.pm, __ATOMIC_RELAXED, __HIP_MEMORY_SCOPE_AGENT)) >= want) break;
                if (__builtin_amdgcn_s_memrealtime() - t0 > 2000000ull) {
                    if (lane == 0) { unsigned expect = 0u; __hip_atomic_compare_exchange_strong(tmo + 1, &expect, code | (unsigned)(u.pm & 0xff), __ATOMIC_RELAXED, __ATOMIC_RELAXED, __HIP_MEMORY_SCOPE_AGENT);
                                     __hip_atomic_store(tmo, 1u, __ATOMIC_RELAXED, __HIP_MEMORY_SCOPE_AGENT); }
                    dead = true; break; }
                __builtin_amdgcn_s_sleep(2);
            }
            __builtin_amdgcn_fence(__ATOMIC_ACQUIRE, "agent");
            if (lane == 0) flag[0] = dead ? 1u : 0u;
        }
        asm volatile("s_waitcnt vmcnt(0) lgkmcnt(0)" ::: "memory"); __builtin_amdgcn_s_barrier(); asm volatile("" ::: "memory");
        const bool bad = flag[0] != 0u;
        if (lane < 32) {
            const unsigned long long* slot = (const unsigned long long*)xbuf + (size_t)(u.pm * BM + row) * 4; float mt[4], m2[4]; float ms = 0.f;
#pragma unroll
            for (int t = 0; t < 4; ++t) { if (t < ntn) { const unsigned long long w = __hip_atomic_load(slot + t, __ATOMIC_RELAXED, __HIP_MEMORY_SCOPE_AGENT); mt[t] = __uint_as_float((unsigned)w); m2[t] = __uint_as_float((unsigned)(w >> 32)); } else { mt[t] = 0.f; m2[t] = 0.f; } ms += mt[t]; }
            const float mean = ms / (float)ntn; float q = 0.f;
#pragma unroll
            for (int t = 0; t < 4; ++t) if (t < ntn) { const float dm = mt[t] - mean; q += m2[t] + 256.0f * dm * dm; }
            S[row] = (f32x2v){mean, 1.0f / sqrtf(q / (256.0f * (float)ntn) + eps)};
        }
        asm volatile("s_waitcnt lgkmcnt(0)" ::: "memory"); __builtin_amdgcn_s_barrier(); asm volatile("" ::: "memory");
        return bad;
    }
};
struct EpiLnRes {
    static constexpr bool PERM = false, AFTER_DRAIN = true;
    const float* base; float* out; int ldc; const float* bias; PanelStats st; unsigned poison;
    __device__ __forceinline__ void fused(f32x4 (&acc)[2][2][4][2], const Unit& u, int wr, int wc, int fr, int fq, PG8_LAS unsigned char* lds, int wid, int lane) const {
        typedef float f32x2v __attribute__((ext_vector_type(2)));
        const PG8_LAS f32x2v* S = (const PG8_LAS f32x2v*)(lds + 8192);
        const int col0 = u.pn * BM + wc * 32 + 4 * fq;
#pragma unroll
        for (int bj = 0; bj < 2; ++bj)
#pragma unroll
            for (int n = 0; n < 2; ++n) { const f32x4 bv = bias ? *(const f32x4*)(bias + col0 + bj * HALF + n * 16) : (f32x4){0.f, 0.f, 0.f, 0.f};
#pragma unroll
                for (int ai = 0; ai < 2; ++ai)
#pragma unroll
                    for (int m = 0; m < 4; ++m) acc[ai][bj][m][n] += bv; }
        f32x4 pre[4][2][2];
#pragma unroll
        for (int m = 0; m < 4; ++m) { const size_t off = (size_t)(u.pm * BM + wr * 64 + m * 16 + fr) * ldc + col0;
#pragma unroll
            for (int bj = 0; bj < 2; ++bj)
#pragma unroll
                for (int n = 0; n < 2; ++n) pre[m][bj][n] = *(const f32x4*)(base + off + bj * HALF + n * 16); }
        const bool bad = st.run(acc, u, wr, wc, fr, fq, lds, wid, lane) || poison != 0u;
        const float qnan = __builtin_nanf("");
#pragma unroll
        for (int ai = 0; ai < 2; ++ai)
#pragma unroll
            for (int m = 0; m < 4; ++m) { const int r = ai * HALF + wr * 64 + m * 16 + fr; const f32x2v sr = S[r]; const size_t off = (size_t)(u.pm * BM + r) * ldc + col0;
#pragma unroll
                for (int bj = 0; bj < 2; ++bj)
#pragma unroll
                    for (int n = 0; n < 2; ++n) { const f32x4 bs = ai == 0 ? pre[m][bj][n] : *(const f32x4*)(base + off + bj * HALF + n * 16); f32x4 o = bs + (acc[ai][bj][m][n] - sr.x) * sr.y;
                        if (bad) o = (f32x4){qnan, qnan, qnan, qnan}; *(f32x4*)(out + off + bj * HALF + n * 16) = o; }
                if (m & 1) asm volatile("" ::: "memory"); }
    }
};
struct EpiLnResLn {
    static constexpr bool PERM = false, AFTER_DRAIN = true;
    const float* base; float* out; bf16_t* xn; int ldc; const float* bias; PanelStats st1, st2; unsigned poison;
    __device__ __forceinline__ void fused(f32x4 (&acc)[2][2][4][2], const Unit& u, int wr, int wc, int fr, int fq, PG8_LAS unsigned char* lds, int wid, int lane) const {
        typedef float f32x2v __attribute__((ext_vector_type(2))); typedef unsigned u32x2v __attribute__((ext_vector_type(2)));
        const PG8_LAS f32x2v* S = (const PG8_LAS f32x2v*)(lds + 8192);
        const int col0 = u.pn * BM + wc * 32 + 4 * fq;
#pragma unroll
        for (int bj = 0; bj < 2; ++bj)
#pragma unroll
            for (int n = 0; n < 2; ++n) { const f32x4 bv = bias ? *(const f32x4*)(bias + col0 + bj * HALF + n * 16) : (f32x4){0.f, 0.f, 0.f, 0.f};
#pragma unroll
                for (int ai = 0; ai < 2; ++ai)
#pragma unroll
                    for (int m = 0; m < 4; ++m) acc[ai][bj][m][n] += bv; }
        bool bad = st1.run(acc, u, wr, wc, fr, fq, lds, wid, lane) || poison != 0u;
        const float qnan = __builtin_nanf("");
#pragma unroll
        for (int ai = 0; ai < 2; ++ai)
#pragma unroll
            for (int m = 0; m < 4; ++m) { const int r = ai * HALF + wr * 64 + m * 16 + fr; const f32x2v sr = S[r]; const size_t off = (size_t)(u.pm * BM + r) * ldc + col0;
#pragma unroll
                for (int bj = 0; bj < 2; ++bj)
#pragma unroll
                    for (int n = 0; n < 2; ++n) { const f32x4 bs = *(const f32x4*)(base + off + bj * HALF + n * 16); acc[ai][bj][m][n] = bs + (acc[ai][bj][m][n] - sr.x) * sr.y; }
                asm volatile("" : "+v"(acc[ai][0][m][0]), "+v"(acc[ai][0][m][1]), "+v"(acc[ai][1][m][0]), "+v"(acc[ai][1][m][1]));
                if (m & 1) asm volatile("" ::: "memory"); }
        const bool bad1 = bad;
        bad = st2.run(acc, u, wr, wc, fr, fq, lds, wid, lane) || bad;
#pragma unroll
        for (int ai = 0; ai < 2; ++ai)
#pragma unroll
            for (int m = 0; m < 4; ++m) { const int r = ai * HALF + wr * 64 + m * 16 + fr; const f32x2v sr = S[r]; const size_t off = (size_t)(u.pm * BM + r) * ldc + col0;
#pragma unroll
                for (int bj = 0; bj < 2; ++bj)
#pragma unroll
                    for (int n = 0; n < 2; ++n) { const f32x4 x1 = acc[ai][bj][m][n]; *(f32x4*)(out + off + bj * HALF + n * 16) = bad1 ? (f32x4){qnan, qnan, qnan, qnan} : x1;
                        const f32x4 o = (x1 - sr.x) * sr.y; u32x2v w; w.x = cvt_pk_bf16(o[0], o[1]); w.y = cvt_pk_bf16(o[2], o[3]);
                        if (bad) { w.x = 0x7fc07fc0u; w.y = 0x7fc07fc0u; } *(u32x2v*)(xn + off + bj * HALF + n * 16) = w; }
                asm volatile("" ::: "memory"); }
    }
};

template <class Epi, class Sched, bool ALIGN_EPI = false, bool SP2 = false>
__device__ __forceinline__ void gemm_phase(PG8_LAS unsigned char* lds, const Gemm g, const Sched& S, const Epi& E) {
    const int tid = threadIdx.x, wid = __builtin_amdgcn_readfirstlane(tid >> 6), lane = tid & 63, wr = wid >> 2, wc = wid & 3, fr = lane & 15, fq = lane >> 4;
    const int K = g.K, nt = K / BK;
    unsigned voffA[2], voffB[2];
#pragma unroll
    for (int i = 0; i < 2; ++i) { int R, C; stage_rc(tid * 16 + i * 8192, R, C); const int Rb = Epi::PERM ? ((R & ~31) + perm32(R & 31)) : R;
        voffA[i] = (unsigned)(R * K + C) * 2u; voffB[i] = (unsigned)(Rb * K + C) * 2u; }
    const size_t kstep = (size_t)(BK * 2);
    const size_t hstep = (size_t)HALF * K * 2;
    const size_t tstep = 2 * hstep;
    const unsigned ldsw = (unsigned)wid * 1024u;
    const int aoff = lds_byte(wr * 64 + fr, fq * 8), boff = lds_byte(wc * 32 + fr, fq * 8);
#define PG8_SA(b, h) (((b) * 2 + (h)) * HTB)
#define PG8_SB(b, h) ((4 + (b) * 2 + (h)) * HTB)
#define PG8_STAGE(bufoff, gbase, voff) do { _Pragma("unroll") for (int _i = 0; _i < 2; ++_i) \
        __builtin_amdgcn_global_load_lds((const unsigned*)((const char*)(gbase) + (voff)[_i]), (PG8_LAS unsigned*)(lds + (bufoff) + ldsw + _i * 8192), 16, 0, 0); } while (0)
#define PG8_LDA(dst, b, h) do { _Pragma("unroll") for (int m = 0; m < 4; ++m) _Pragma("unroll") for (int k = 0; k < 2; ++k) dst[m][k] = *(const PG8_LAS bf16x8*)(lds + PG8_SA(b, h) + aoff + m * 2048 + k * 1024); } while (0)
#define PG8_LDB(dst, b, h) do { _Pragma("unroll") for (int n = 0; n < 2; ++n) _Pragma("unroll") for (int k = 0; k < 2; ++k) dst[n][k] = *(const PG8_LAS bf16x8*)(lds + PG8_SB(b, h) + boff + n * 2048 + k * 1024); } while (0)
#define PG8_MMA(ai, bj, At, Bt) do { __builtin_amdgcn_s_setprio(1); _Pragma("unroll") for (int m = 0; m < 4; ++m) _Pragma("unroll") for (int n = 0; n < 2; ++n) _Pragma("unroll") for (int k = 0; k < 2; ++k) \
        acc[ai][bj][m][n] = __builtin_amdgcn_mfma_f32_16x16x32_bf16(Bt[n][k], At[m][k], acc[ai][bj][m][n], 0, 0, 0); __builtin_amdgcn_s_setprio(0); } while (0)
#define PG8_WAIT_V(n) asm volatile("s_waitcnt vmcnt(" #n ")" ::: "memory")
#define PG8_WAIT_L(n) asm volatile("s_waitcnt lgkmcnt(" #n ")" ::: "memory")
#define PG8_BAR __builtin_amdgcn_s_barrier()
#define PG8_SCHED __builtin_amdgcn_sched_barrier(0)
    Unit cur, nxt; int ui = 0;
    if (!S.next(0, cur)) return;
    f32x4 acc[2][2][4][2];
#pragma unroll
    for (int a = 0; a < 2; ++a)
#pragma unroll
        for (int b = 0; b < 2; ++b)
#pragma unroll
            for (int m = 0; m < 4; ++m)
#pragma unroll
                for (int n = 0; n < 2; ++n) acc[a][b][m][n] = (f32x4){0.f, 0.f, 0.f, 0.f};
    bf16x8 At[4][2], B0[2][2], B1[2][2];
    const char* cA = (const char*)g.A + (size_t)cur.pm * tstep; const char* cB = (const char*)g.Bt + (size_t)cur.pn * tstep;
    S.a_ready(cur);
    if constexpr (SP2) {
        PG8_STAGE(PG8_SB(0, 0), cB, voffB); PG8_STAGE(PG8_SB(0, 1), cB + hstep, voffB); PG8_STAGE(PG8_SA(0, 0), cA, voffA); PG8_STAGE(PG8_SA(0, 1), cA + hstep, voffA);
        if (wr == 1) PG8_BAR;
        PG8_WAIT_V(2); PG8_BAR;
        PG8_STAGE(PG8_SB(1, 0), cB + kstep, voffB); PG8_STAGE(PG8_SA(1, 0), cA + kstep, voffA); PG8_STAGE(PG8_SB(1, 1), cB + hstep + kstep, voffB);
        PG8_WAIT_V(6); PG8_BAR;
    } else {
        PG8_STAGE(PG8_SB(0, 0), cB, voffB); PG8_STAGE(PG8_SA(0, 0), cA, voffA); PG8_STAGE(PG8_SB(0, 1), cB + hstep, voffB); PG8_STAGE(PG8_SA(0, 1), cA + hstep, voffA);
        if (wr == 1) PG8_BAR;
        PG8_WAIT_V(4); PG8_BAR;
        PG8_STAGE(PG8_SB(1, 0), cB + kstep, voffB); PG8_STAGE(PG8_SA(1, 0), cA + kstep, voffA); PG8_STAGE(PG8_SB(1, 1), cB + hstep + kstep, voffB);
        PG8_WAIT_V(6); PG8_BAR;
    }
    for (;;) {
        const bool has_next = S.next(ui + 1, nxt);
        const char* nA = has_next ? (const char*)g.A + (size_t)nxt.pm * tstep : cA; const char* nB = has_next ? (const char*)g.Bt + (size_t)nxt.pn * tstep : cB;
        for (int t = 0; t < nt; t += 2) {
            const bool last = (t == nt - 2);
            const char* a1 = cA + (size_t)(t + 1) * kstep;
            const char* a2 = last ? nA : cA + (size_t)(t + 2) * kstep; const char* b2 = last ? nB : cB + (size_t)(t + 2) * kstep;
            const char* a3 = a2 + kstep; const char* b3 = b2 + kstep;
            if (last && has_next) S.a_ready(nxt);
            if constexpr (SP2) {
            PG8_LDB(B0, 0, 0); PG8_LDB(B1, 0, 1); PG8_SCHED; PG8_LDA(At, 0, 0); PG8_STAGE(PG8_SA(1, 1), a1 + hstep, voffA);
            PG8_WAIT_V(8); PG8_WAIT_L(0); PG8_BAR; PG8_MMA(0, 0, At, B0); PG8_MMA(0, 1, At, B1); PG8_BAR; PG8_SCHED;
            PG8_LDA(At, 0, 1); PG8_STAGE(PG8_SB(0, 0), b2, voffB); PG8_STAGE(PG8_SB(0, 1), b2 + hstep, voffB); PG8_STAGE(PG8_SA(0, 0), a2, voffA);
            PG8_WAIT_V(8); PG8_WAIT_L(0); PG8_BAR; PG8_MMA(1, 0, At, B0); PG8_MMA(1, 1, At, B1); PG8_BAR; PG8_SCHED;
            PG8_LDB(B0, 1, 0); PG8_LDB(B1, 1, 1); PG8_SCHED; PG8_LDA(At, 1, 0); PG8_STAGE(PG8_SA(0, 1), a2 + hstep, voffA);
            PG8_WAIT_V(8); PG8_WAIT_L(0); PG8_BAR; PG8_MMA(0, 0, At, B0); PG8_MMA(0, 1, At, B1); PG8_BAR; PG8_SCHED;
            PG8_LDA(At, 1, 1); PG8_STAGE(PG8_SB(1, 0), b3, voffB); PG8_STAGE(PG8_SB(1, 1), b3 + hstep, voffB); PG8_STAGE(PG8_SA(1, 0), a3, voffA);
            PG8_WAIT_V(8); PG8_WAIT_L(0); PG8_BAR; PG8_MMA(1, 0, At, B0); PG8_MMA(1, 1, At, B1); PG8_BAR; PG8_SCHED;
            } else {
            PG8_LDB(B0, 0, 0); PG8_SCHED; PG8_LDA(At, 0, 0); PG8_STAGE(PG8_SA(1, 1), a1 + hstep, voffA);
            PG8_WAIT_L(8); PG8_BAR; PG8_WAIT_L(0); PG8_MMA(0, 0, At, B0); PG8_BAR; PG8_SCHED;
            PG8_LDB(B1, 0, 1); PG8_STAGE(PG8_SB(0, 0), b2, voffB);
            PG8_BAR; PG8_WAIT_L(0); PG8_MMA(0, 1, At, B1); PG8_BAR;
            PG8_LDA(At, 0, 1); PG8_STAGE(PG8_SA(0, 0), a2, voffA);
            PG8_BAR; PG8_WAIT_L(0); PG8_MMA(1, 0, At, B0); PG8_BAR; PG8_SCHED;
            PG8_STAGE(PG8_SB(0, 1), b2 + hstep, voffB);
            PG8_WAIT_V(6); PG8_BAR; PG8_MMA(1, 1, At, B1); PG8_BAR;
            PG8_LDB(B0, 1, 0); PG8_SCHED; PG8_LDA(At, 1, 0); PG8_STAGE(PG8_SA(0, 1), a2 + hstep, voffA);
            PG8_WAIT_L(8); PG8_BAR; PG8_WAIT_L(0); PG8_MMA(0, 0, At, B0); PG8_BAR; PG8_SCHED;
            PG8_LDB(B1, 1, 1); PG8_STAGE(PG8_SB(1, 0), b3, voffB);
            PG8_BAR; PG8_WAIT_L(0); PG8_MMA(0, 1, At, B1); PG8_BAR;
            PG8_LDA(At, 1, 1); PG8_STAGE(PG8_SA(1, 0), a3, voffA);
            PG8_BAR; PG8_WAIT_L(0); PG8_MMA(1, 0, At, B0); PG8_BAR; PG8_SCHED;
            PG8_STAGE(PG8_SB(1, 1), b3 + hstep, voffB);
            PG8_WAIT_V(6); PG8_BAR; PG8_MMA(1, 1, At, B1); PG8_BAR;
            }
        }
        if constexpr (ALIGN_EPI) { if (wr == 0) PG8_BAR; }
        if constexpr (!Epi::AFTER_DRAIN) { E(acc, cur, wr, wc, fr, fq); S.done(cur); }
        if (!has_next) break;
#pragma unroll
        for (int a = 0; a < 2; ++a)
#pragma unroll
            for (int b = 0; b < 2; ++b)
#pragma unroll
                for (int m = 0; m < 4; ++m)
#pragma unroll
                    for (int n = 0; n < 2; ++n) acc[a][b][m][n] = (f32x4){0.f, 0.f, 0.f, 0.f};
        cur = nxt; cA = nA; cB = nB; ++ui;
        if constexpr (ALIGN_EPI) { if (wr == 1) PG8_BAR; }
    }
    PG8_WAIT_V(0);
    if constexpr (!ALIGN_EPI) { if (wr == 0) PG8_BAR; }
    PG8_BAR;
    if constexpr (Epi::AFTER_DRAIN) { E.fused(acc, cur, wr, wc, fr, fq, lds, wid, lane); S.done(cur); }
#undef PG8_SA
#undef PG8_SB
#undef PG8_STAGE
#undef PG8_LDA
#undef PG8_LDB
#undef PG8_MMA
#undef PG8_WAIT_V
#undef PG8_WAIT_L
#undef PG8_BAR
#undef PG8_SCHED
}
}
namespace pg8 {
__device__ __forceinline__ float silu_f(float x) { return x * __builtin_amdgcn_rcpf(1.0f + __expf(-x)); }
__device__ __forceinline__ float sigm_f(float x) { return __builtin_amdgcn_rcpf(1.0f + __expf(-x)); }
struct EpiSwiglu {
    static constexpr bool PERM = true, AFTER_DRAIN = false;
    bf16_t* O; int ldc;
    __device__ __forceinline__ void operator()(const f32x4 (&acc)[2][2][4][2], const Unit& u, int wr, int wc, int fr, int fq) const {
        const int row0 = u.pm * BM + wr * 64 + fr, col0 = u.pn * HALF + wc * 32 + 8 * fq;
#pragma unroll
        for (int ai = 0; ai < 2; ++ai)
#pragma unroll
            for (int m = 0; m < 4; ++m) {
                bf16_t* rowp = O + (size_t)(row0 + ai * HALF + m * 16) * ldc + col0;
                const f32x4 a0 = acc[ai][0][m][0], a1 = acc[ai][0][m][1], b0 = acc[ai][1][m][0], b1 = acc[ai][1][m][1];
                u32x4 w;
                w.x = cvt_pk_bf16(silu_f(a0[0]) * b0[0], silu_f(a0[1]) * b0[1]); w.y = cvt_pk_bf16(silu_f(a0[2]) * b0[2], silu_f(a0[3]) * b0[3]);
                w.z = cvt_pk_bf16(silu_f(a1[0]) * b1[0], silu_f(a1[1]) * b1[1]); w.w = cvt_pk_bf16(silu_f(a1[2]) * b1[2], silu_f(a1[3]) * b1[3]);
                *(u32x4*)rowp = w;
            }
    }
};
struct EpiF32 {
    static constexpr bool PERM = false, AFTER_DRAIN = false;
    float* O; int ldc;
    __device__ __forceinline__ void operator()(const f32x4 (&acc)[2][2][4][2], const Unit& u, int wr, int wc, int fr, int fq) const {
        const int row0 = u.pm * BM + wr * 64 + fr, col0 = u.pn * BM + wc * 32 + 4 * fq;
#pragma unroll
        for (int ai = 0; ai < 2; ++ai)
#pragma unroll
            for (int m = 0; m < 4; ++m) {
                float* rowp = O + (size_t)(row0 + ai * HALF + m * 16) * ldc + col0;
#pragma unroll
                for (int bj = 0; bj < 2; ++bj)
#pragma unroll
                    for (int n = 0; n < 2; ++n) *(f32x4*)(rowp + bj * HALF + n * 16) = acc[ai][bj][m][n];
            }
    }
};
template <int ACT  > struct EpiStoreBf16 {
    static constexpr bool PERM = true, AFTER_DRAIN = false;
    bf16_t* O; int ldc;
    __device__ __forceinline__ void operator()(const f32x4 (&acc)[2][2][4][2], const Unit& u, int wr, int wc, int fr, int fq) const {
        const int row0 = u.pm * BM + wr * 64 + fr, col0 = u.pn * BM + wc * 32 + 8 * fq;
#pragma unroll
        for (int ai = 0; ai < 2; ++ai)
#pragma unroll
            for (int m = 0; m < 4; ++m) {
                bf16_t* rowp = O + (size_t)(row0 + ai * HALF + m * 16) * ldc + col0;
#pragma unroll
                for (int bj = 0; bj < 2; ++bj) {
                    f32x4 v0 = acc[ai][bj][m][0], v1 = acc[ai][bj][m][1];
                    if (ACT == 2) {
#pragma unroll
                        for (int i = 0; i < 4; ++i) { v0[i] = sigm_f(v0[i]); v1[i] = sigm_f(v1[i]); }
                    }
                    u32x4 w; w.x = cvt_pk_bf16(v0[0], v0[1]); w.y = cvt_pk_bf16(v0[2], v0[3]); w.z = cvt_pk_bf16(v1[0], v1[1]); w.w = cvt_pk_bf16(v1[2], v1[3]);
                    *(u32x4*)(rowp + bj * HALF) = w;
                }
            }
    }
};
}

#ifndef DBG_SKIP_FFN2
#define DBG_SKIP_FFN2 0
#endif
#ifndef DBG_SKIP_MIXER
#define DBG_SKIP_MIXER 0
#endif
#ifndef DBG_GATE_HALF
#define DBG_GATE_HALF 0
#endif
#ifndef DBG_GATE_RAW
#define DBG_GATE_RAW 0
#endif
#ifndef DBG_ZERO_BR
#define DBG_ZERO_BR 0
#endif
#ifndef NAIVE_DSA
#define NAIVE_DSA 1
#endif
#ifndef NAIVE_MLA
#define NAIVE_MLA 1
#endif
#ifndef NAIVE_RET
#define NAIVE_RET 1
#endif
#ifndef NAIVE_S5
#define NAIVE_S5 1
#endif
constexpr int NWAVES = 8;
constexpr int NB = 4, SEQ = 4096, T = NB * SEQ, DM = 1024, DFF = 2816, NINA = 2304, NGATE = 4096, NINSRC = 6340, DEPTH = 2;
constexpr int HA_DQ = 0, HA_DK = 256, HA_DV = 320, HA_IQ = 384, HA_IK = 512, HA_IW = 544, HA_RQ = 576, HA_RK = 832, HA_RV = 1088, HA_RG = 1344,
              HA_SU = 1600, HA_CQ = 1856, HA_CKV = 2112, HA_KR = 2240;
constexpr float DN_ALPHA = 1.41421356237309515f;
constexpr float LN_EPS = 1e-5f, RMS_EPS = 1e-6f;

constexpr size_t MiB = 1u << 20;
constexpr size_t WS_CTL = 0, CTL_ZERO_BYTES = 1 * MiB;
constexpr size_t WS_XBUF = 1 * MiB;
constexpr size_t WS_ROPE = 5 * MiB;
constexpr size_t WS_S5LAM = 5 * MiB + 512 * 1024;
constexpr size_t WS_S5LAM64 = WS_S5LAM + 8192;
constexpr size_t WS_S5BBAR = WS_S5LAM + 65536;
constexpr size_t WS_WI = 6 * MiB, WS_WO = 28 * MiB, WS_WIN = 39 * MiB, WS_WG = 44 * MiB, WS_WOUT = 52 * MiB, WS_WB = 54 * MiB,
                 WS_WGLU = 56 * MiB, WS_WUQ = 56 * MiB + 512 * 1024, WS_WUKV = 57 * MiB;
constexpr size_t WS_XN = 58 * MiB, WS_BR = 90 * MiB, WS_BIG = 122 * MiB;
constexpr size_t WS_G = WS_BIG, WS_HA = WS_BIG, WS_GATES = WS_BIG;
constexpr size_t WS_MQ = 194 * MiB, WS_MKV = 206 * MiB, WS_MKR = 222 * MiB, WS_RKV = 223 * MiB, WS_S5E = 239 * MiB;
constexpr size_t WS_MERGED = WS_XN;
constexpr size_t WS_Z = 256 * MiB, WS_END = 320 * MiB;

constexpr int LDS_BYTES = 147456;

#define GAS __attribute__((address_space(1)))
#define LAS __attribute__((address_space(3)))
typedef unsigned short bf16;
typedef unsigned v4u __attribute__((ext_vector_type(4)));
typedef unsigned v2u __attribute__((ext_vector_type(2)));
typedef float f32x4 __attribute__((ext_vector_type(4)));
typedef float f32x2 __attribute__((ext_vector_type(2)));
#define LDS_WAIT() asm volatile("s_waitcnt lgkmcnt(0)" ::: "memory")
#define VM_WAIT() asm volatile("s_waitcnt vmcnt(0)" ::: "memory")
__device__ __forceinline__ unsigned f2bf(float f) { unsigned u = __builtin_bit_cast(unsigned, f); return (u + 0x7fffu + ((u >> 16) & 1u)) >> 16; }
__device__ __forceinline__ unsigned pk2(float lo, float hi) { return f2bf(lo) | (f2bf(hi) << 16); }
__device__ __forceinline__ float bf2f(bf16 v) { return __uint_as_float((unsigned)v << 16); }
__device__ __forceinline__ void ld8(const bf16* p, float* o) {
    const v4u u = *(const v4u*)p;
    o[0] = __uint_as_float(u.x << 16); o[1] = __uint_as_float(u.x & 0xffff0000u); o[2] = __uint_as_float(u.y << 16); o[3] = __uint_as_float(u.y & 0xffff0000u);
    o[4] = __uint_as_float(u.z << 16); o[5] = __uint_as_float(u.z & 0xffff0000u); o[6] = __uint_as_float(u.w << 16); o[7] = __uint_as_float(u.w & 0xffff0000u);
}
__device__ __forceinline__ float wave_sum(float v) {
#pragma unroll
    for (int o = 1; o < 64; o <<= 1) v += __shfl_xor(v, o);
    return v;
}
__device__ __forceinline__ float wave_max(float v) {
#pragma unroll
    for (int o = 1; o < 64; o <<= 1) v = fmaxf(v, __shfl_xor(v, o));
    return v;
}
__device__ __forceinline__ int wave_sum_i(int v) {
#pragma unroll
    for (int o = 1; o < 64; o <<= 1) v += __shfl_xor(v, o);
    return v;
}
__device__ __forceinline__ float silu_f(float x) { return x / (1.0f + __expf(-x)); }
__device__ __forceinline__ float sigm_f(float x) { return 1.0f / (1.0f + __expf(-x)); }
__device__ __forceinline__ float gelu_tanh(float x) {
    const float z = 0.7978845608028654f * (x + 0.044715f * x * x * x);
    const float th = 1.0f - 2.0f / (__expf(2.0f * z) + 1.0f);
    return 0.5f * x * (1.0f + th);
}

#define RLX_AGENT __ATOMIC_RELAXED, __HIP_MEMORY_SCOPE_AGENT
#define XB_TMO      128
#define XB_XCNT(j)  (256  + 64 * (j))
#define XB_XSUB(j)  (1280 + 64 * (j))
#define XB_XGEN(j)  (2304 + 64 * (j))
#define XB_TOP      3328
#define XB_TOPGEN   3392
#define XCD_BAR_WORDS 3456
#define XB_SPIN_CAP (1u << 18)

__device__ __forceinline__ unsigned xb_ld(unsigned* p)              { return __hip_atomic_load(p, __ATOMIC_RELAXED, __HIP_MEMORY_SCOPE_AGENT); }
__device__ __forceinline__ unsigned xb_add(unsigned* p, unsigned v) { return __hip_atomic_fetch_add(p, v, __ATOMIC_RELAXED, __HIP_MEMORY_SCOPE_AGENT); }
__device__ __forceinline__ unsigned xb_xcc_id() { return (unsigned)__builtin_amdgcn_s_getreg((3 << 11) | 20) & 0xFu; }
#define XB_SPIN(cond, bar) do { unsigned _sp = 0; while (cond) { __builtin_amdgcn_s_sleep(1); \
    if ((++_sp & 255u) == 0u) { if (xb_ld(&(bar)[XB_TMO])) break; if (_sp > XB_SPIN_CAP) { atomicAdd(&(bar)[XB_TMO], 1u); break; } } } } while (0)

struct XcdBarrier {
    unsigned* bar; unsigned x;
    volatile LAS unsigned* st;
};

__device__ __forceinline__ XcdBarrier xcd_barrier_post(unsigned* bar, volatile LAS unsigned* st) {
    XcdBarrier b; b.bar = bar; b.x = xb_xcc_id(); b.st = st;
    if (threadIdx.x == 0) (void)xb_add(&bar[XB_XCNT(b.x)], 1u);
    return b;
}
__device__ __forceinline__ void xcd_barrier_complete(unsigned* bar, unsigned x, unsigned& nloc, unsigned& nx) {
    const unsigned G = gridDim.x * gridDim.y * gridDim.z;
    unsigned sum, cnt, mine, sp = 0u;
    for (;;) {
        sum = 0u; cnt = 0u; mine = 0u;
#pragma unroll
        for (unsigned j = 0; j < 16; ++j) { const unsigned c = xb_ld(&bar[XB_XCNT(j)]); sum += c; cnt += (c > 0u) ? 1u : 0u; mine = (j == x) ? c : mine; }
        if (sum == G) break;
        __builtin_amdgcn_s_sleep(1);
        if ((++sp & 255u) == 0u) { if (xb_ld(&bar[XB_TMO])) break; if (sp > XB_SPIN_CAP) { atomicAdd(&bar[XB_TMO], 1u); break; } }
    }
    nloc = mine > 0u ? mine : 1u; nx = cnt > 0u ? cnt : 1u;
}

__device__ __forceinline__ void xcd_barrier(const XcdBarrier& b) {
    asm volatile("s_waitcnt vmcnt(0)" ::: "memory");
    __syncthreads();
    if (threadIdx.x == 0) {
        unsigned* bar = b.bar;
        __builtin_amdgcn_s_waitcnt(0);
        unsigned nloc = b.st[0], nx = b.st[1];
        if (nloc == 0u) { xcd_barrier_complete(bar, b.x, nloc, nx); b.st[0] = nloc; b.st[1] = nx; }
        const unsigned old = xb_add(&bar[XB_XSUB(b.x)], 1u);
        const unsigned gen = old / nloc;
        if (old + 1u == (gen + 1u) * nloc) {
            __builtin_amdgcn_fence(__ATOMIC_RELEASE, "agent");
            asm volatile("s_waitcnt vmcnt(0)" ::: "memory");
            const unsigned og = xb_add(&bar[XB_TOP], 1u);
            const unsigned tg = og / nx;
            if (og + 1u == (tg + 1u) * nx) xb_add(&bar[XB_TOPGEN], 1u);
            else XB_SPIN(xb_ld(&bar[XB_TOPGEN]) == tg, bar);
            __builtin_amdgcn_fence(__ATOMIC_ACQUIRE, "agent");
            xb_add(&bar[XB_XGEN(b.x)], 1u);
            asm volatile("s_waitcnt vmcnt(0)" ::: "memory");
        } else {
            XB_SPIN(xb_ld(&bar[XB_XGEN(b.x)]) == gen, bar);
            __builtin_amdgcn_fence(__ATOMIC_ACQUIRE, "agent");
            asm volatile("s_waitcnt vmcnt(0)" ::: "memory");
        }
    }
    __syncthreads();
}

constexpr int CW_BAR = 4096;
struct Args { const float* in[22]; float* out; unsigned char* ws; int ph_lo, ph_hi; };

struct Ctx {
    LAS unsigned char* lds;
    int tid, lane, wave, G, gw, NGW, gtid, NT;
};

template <class Map>
__device__ __forceinline__ void transpose_w(const Ctx& C, const float* W, int K, int Nsrc, bf16* WT, int Ndst, Map map) {
    LAS float* scr = (LAS float*)(C.lds + C.wave * 16384);
    const int lane = C.lane, nblk = Ndst / 32, items = (K / 64) * nblk;
    for (int it = C.gw; it < items; it += C.NGW) {
        const int kb = it / nblk, nb = it % nblk, k0 = 64 * kb, n0 = 32 * nb;
        const int sc = map(n0 + (lane & 31));
#pragma unroll 8
        for (int i = 0; i < 32; ++i) { const int kk = 2 * i + (lane >> 5); scr[kk * 33 + (lane & 31)] = sc >= 0 ? W[(size_t)(k0 + kk) * Nsrc + sc] : 0.f; }
        LDS_WAIT();
        const int c = lane & 7;
#pragma unroll
        for (int j = 0; j < 4; ++j) {
            const int n = (lane >> 3) + 8 * j; const LAS float* s = scr + (8 * c) * 33 + n;
            v4u o; o.x = pk2(s[0 * 33], s[1 * 33]); o.y = pk2(s[2 * 33], s[3 * 33]); o.z = pk2(s[4 * 33], s[5 * 33]); o.w = pk2(s[6 * 33], s[7 * 33]);
            *(v4u*)(WT + (size_t)(n0 + n) * K + k0 + 8 * c) = o;
        }
        LDS_WAIT();
    }
}

__device__ __forceinline__ void phase_prep(const Ctx& C, const Args& a, int l) {
    unsigned char* ws = a.ws;
    for (int f = 0; f < 2; ++f) {
        transpose_w(C, a.in[3] + (size_t)(l * 2 + f) * DM * 2 * DFF, DM, 2 * DFF, (bf16*)(ws + WS_WI) + (size_t)f * 2 * DFF * DM, 2 * DFF,
                    [](int n) { const int blk = n >> 8, r = n & 255; return r < 128 ? blk * 128 + r : DFF + blk * 128 + (r - 128); });
        transpose_w(C, a.in[4] + (size_t)(l * 2 + f) * DFF * DM, DFF, DM, (bf16*)(ws + WS_WO) + (size_t)f * DM * DFF, DM, [](int n) { return n; });
    }
    transpose_w(C, a.in[5] + (size_t)l * DM * NINSRC, DM, NINSRC, (bf16*)(ws + WS_WIN), NINA,
                [](int n) { return n < 548 ? n : (n < 576 ? -1 : (n < 2272 ? n - 28 : -1)); });
    transpose_w(C, a.in[5] + (size_t)l * DM * NINSRC, DM, NINSRC, (bf16*)(ws + WS_WG), NGATE, [](int n) { return 2244 + n; });
    transpose_w(C, a.in[21] + (size_t)l * DM * DM, DM, DM, (bf16*)(ws + WS_WOUT), DM, [](int n) { return n; });
    for (int n4 = 0; n4 < 4; ++n4)
        transpose_w(C, a.in[20] + (size_t)(l * 4 + n4) * 256 * DM, 256, DM, (bf16*)(ws + WS_WB) + (size_t)n4 * DM * 256, DM, [](int n) { return n; });
    transpose_w(C, a.in[15] + (size_t)l * 256 * 512, 256, 512, (bf16*)(ws + WS_WGLU), 512, [](int n) { return n; });
    transpose_w(C, a.in[18] + (size_t)l * 256 * 384, 256, 384, (bf16*)(ws + WS_WUQ), 384, [](int n) { return n; });
    transpose_w(C, a.in[19] + (size_t)l * 128 * 512, 128, 512, (bf16*)(ws + WS_WUKV), 512, [](int n) { return n; });
    if (C.gtid < 1024) {
        const int g = C.gtid >> 6, p = C.gtid & 63, gi = l * 1024 + g * 64 + p;
        const double are = (double)a.in[7][gi], aim = (double)a.in[8][gi];
        const double dt = (double)__expf(a.in[14][l * 16 + g]);
        const double TWO_PI = 6.283185307179586476925286766559;
        float2* lam = (float2*)(ws + WS_S5LAM); float2* lam64 = (float2*)(ws + WS_S5LAM64); float2* bbar = (float2*)(ws + WS_S5BBAR);
        const double er = (double)__expf((float)(are * dt));
        double rev = aim * dt / TWO_PI; rev -= __builtin_rint(rev);
        const double cr = (double)__builtin_amdgcn_cosf((float)rev), sr = (double)__builtin_amdgcn_sinf((float)rev);
        const double lr = er * cr, li = er * sr;
        lam[g * 64 + p] = make_float2((float)lr, (float)li);
        const double er64 = (double)__expf((float)(64.0 * are * dt));
        double rev64 = 64.0 * aim * dt / TWO_PI; rev64 -= __builtin_rint(rev64);
        lam64[g * 64 + p] = make_float2((float)(er64 * (double)__builtin_amdgcn_cosf((float)rev64)), (float)(er64 * (double)__builtin_amdgcn_sinf((float)rev64)));
        const double nr = lr - 1.0, ni = li, den = are * are + aim * aim;
        const double qr = (nr * are + ni * aim) / den, qi = (ni * are - nr * aim) / den;
        for (int c = 0; c < 16; ++c) {
            const double br = (double)a.in[9][(size_t)gi * 16 + c], bi = (double)a.in[10][(size_t)gi * 16 + c];
            bbar[(size_t)(g * 64 + p) * 16 + c] = make_float2((float)(qr * br - qi * bi), (float)(qr * bi + qi * br));
        }
    }
    for (int idx = C.gtid; idx < SEQ * 16; idx += C.NT) {
        const int pos = idx >> 4, i = idx & 15;
        const double f4[4] = {1.0, 0.56234132519034908, 0.31622776601683794, 0.17782794100389228};
        double fr = (i & 3) == 0 ? f4[0] : ((i & 3) == 1 ? f4[1] : ((i & 3) == 2 ? f4[2] : f4[3]));
        fr *= (i >> 2) == 0 ? 1.0 : ((i >> 2) == 1 ? 0.1 : ((i >> 2) == 2 ? 0.01 : 0.001));
        double rev = (double)pos * fr / 6.283185307179586476925286766559; rev -= __builtin_floor(rev);
        ((float2*)(ws + WS_ROPE))[idx] = make_float2(__builtin_amdgcn_cosf((float)rev), __builtin_amdgcn_sinf((float)rev));
    }
    if (l == 0) {
        const f32x4* x4 = (const f32x4*)a.in[0]; v2u* o = (v2u*)(ws + WS_XN);
        for (size_t i = C.gtid; i < (size_t)T * DM / 4; i += C.NT) { const f32x4 v = x4[i]; v2u w; w.x = pk2(v[0], v[1]); w.y = pk2(v[2], v[3]); o[i] = w; }
    }
}

__device__ __forceinline__ void phase_ln(const Ctx& C, const float* base, const float* Z, float zc, const float* g, const float* b, float* X, bf16* XN) {
    for (int row = C.gw; row < T; row += C.NGW) {
        const f32x4* b4 = (const f32x4*)(base + (size_t)row * DM) + C.lane; const f32x4* z4 = (const f32x4*)(Z + (size_t)row * DM) + C.lane;
        f32x4 v[4]; float s = 0.f;
#pragma unroll
        for (int j = 0; j < 4; ++j) { v[j] = b4[64 * j] * DN_ALPHA + z4[64 * j] * zc; s += (v[j][0] + v[j][1]) + (v[j][2] + v[j][3]); }
        const float mean = wave_sum(s) * (1.f / DM); float s2 = 0.f;
#pragma unroll
        for (int j = 0; j < 4; ++j) { v[j] = v[j] - mean; s2 += (v[j][0] * v[j][0] + v[j][1] * v[j][1]) + (v[j][2] * v[j][2] + v[j][3] * v[j][3]); }
        const float rstd = 1.f / sqrtf(wave_sum(s2) * (1.f / DM) + LN_EPS);
        f32x4* x4 = (f32x4*)(X + (size_t)row * DM) + C.lane; v2u* o2 = (v2u*)(XN + (size_t)row * DM) + C.lane;
#pragma unroll
        for (int j = 0; j < 4; ++j) {
            const f32x4 gg = ((const f32x4*)g)[C.lane + 64 * j], bb = ((const f32x4*)b)[C.lane + 64 * j];
            const f32x4 o = v[j] * rstd * gg + bb; x4[64 * j] = o;
            v2u w; w.x = pk2(o[0], o[1]); w.y = pk2(o[2], o[3]); o2[64 * j] = w;
        }
    }
}

__device__ __forceinline__ void phase_mixprep_naive(const Ctx& C, const Args& a, int l) {
    unsigned char* ws = a.ws;
    const bf16* HA = (const bf16*)(ws + WS_HA);
    const int lane = C.lane;
    {
        LAS float* qn = (LAS float*)(C.lds + C.wave * 12288);
        LAS float* kvn = qn + 1024;
        LAS float* qo = kvn + 512;
        const float* wuq = a.in[18] + (size_t)l * 256 * 384; const float* wukv = a.in[19] + (size_t)l * 128 * 512;
        const float* qnw = a.in[16] + l * 256; const float* kvnw = a.in[17] + l * 128;
        bf16* MQ = (bf16*)(ws + WS_MQ); bf16* MKV = (bf16*)(ws + WS_MKV); bf16* MKR = (bf16*)(ws + WS_MKR);
        const float2* rope = (const float2*)(ws + WS_ROPE);
        for (int it = C.gw; it < T / 4; it += C.NGW) {
            const int t0 = it * 4;
            for (int k = 0; k < 4; ++k) {
                const bf16* row = HA + (size_t)(t0 + k) * NINA;
                float x[4]; float ss = 0.f;
#pragma unroll
                for (int i = 0; i < 4; ++i) { x[i] = bf2f(row[HA_CQ + lane * 4 + i]); ss += x[i] * x[i]; }
                const float r = 1.f / sqrtf(wave_sum(ss) * (1.f / 256.f) + RMS_EPS);
#pragma unroll
                for (int i = 0; i < 4; ++i) qn[k * 256 + lane * 4 + i] = x[i] * r * qnw[lane * 4 + i];
                float y[2]; float s2 = 0.f;
#pragma unroll
                for (int i = 0; i < 2; ++i) { y[i] = bf2f(row[HA_CKV + lane * 2 + i]); s2 += y[i] * y[i]; }
                const float r2 = 1.f / sqrtf(wave_sum(s2) * (1.f / 128.f) + RMS_EPS);
#pragma unroll
                for (int i = 0; i < 2; ++i) kvn[k * 128 + lane * 2 + i] = y[i] * r2 * kvnw[lane * 2 + i];
            }
            LDS_WAIT();
            {
                float acc[4][6];
#pragma unroll
                for (int k = 0; k < 4; ++k)
#pragma unroll
                    for (int i = 0; i < 6; ++i) acc[k][i] = 0.f;
                for (int kk = 0; kk < 256; ++kk) {
                    float w[6];
#pragma unroll
                    for (int i = 0; i < 6; ++i) w[i] = wuq[(size_t)kk * 384 + lane + 64 * i];
#pragma unroll
                    for (int k = 0; k < 4; ++k) { const float xv = qn[k * 256 + kk];
#pragma unroll
                        for (int i = 0; i < 6; ++i) acc[k][i] += xv * w[i]; }
                }
#pragma unroll
                for (int k = 0; k < 4; ++k)
#pragma unroll
                    for (int i = 0; i < 6; ++i) qo[k * 384 + lane + 64 * i] = acc[k][i];
            }
            LDS_WAIT();
#pragma unroll
            for (int r = 0; r < 4; ++r) {
                const int pi = lane + 64 * r, k = pi >> 6, h = (pi >> 4) & 3, i = pi & 15;
                const int pos = (t0 + k) & (SEQ - 1); const float2 cs = rope[pos * 16 + i];
                const float x1 = qo[k * 384 + h * 96 + 64 + i], x2 = qo[k * 384 + h * 96 + 80 + i];
                qo[k * 384 + h * 96 + 64 + i] = x1 * cs.x - x2 * cs.y; qo[k * 384 + h * 96 + 80 + i] = x1 * cs.y + x2 * cs.x;
            }
            LDS_WAIT();
#pragma unroll
            for (int k = 0; k < 4; ++k)
#pragma unroll
                for (int i = 0; i < 6; ++i) MQ[(size_t)(t0 + k) * 384 + lane + 64 * i] = (bf16)f2bf(qo[k * 384 + lane + 64 * i] * 0.10206207261596575f);
            {
                float acc[4][8];
#pragma unroll
                for (int k = 0; k < 4; ++k)
#pragma unroll
                    for (int i = 0; i < 8; ++i) acc[k][i] = 0.f;
                for (int kk = 0; kk < 128; ++kk) {
                    float w[8];
#pragma unroll
                    for (int i = 0; i < 8; ++i) w[i] = wukv[(size_t)kk * 512 + lane + 64 * i];
#pragma unroll
                    for (int k = 0; k < 4; ++k) { const float xv = kvn[k * 128 + kk];
#pragma unroll
                        for (int i = 0; i < 8; ++i) acc[k][i] += xv * w[i]; }
                }
#pragma unroll
                for (int k = 0; k < 4; ++k)
#pragma unroll
                    for (int i = 0; i < 8; ++i) MKV[(size_t)(t0 + k) * 512 + lane + 64 * i] = (bf16)f2bf(acc[k][i]);
            }
            {
                const int k = lane >> 4, i = lane & 15; const bf16* row = HA + (size_t)(t0 + k) * NINA + HA_KR;
                const int pos = (t0 + k) & (SEQ - 1); const float2 cs = rope[pos * 16 + i];
                const float x1 = bf2f(row[i]), x2 = bf2f(row[16 + i]);
                MKR[(size_t)(t0 + k) * 32 + i] = (bf16)f2bf(x1 * cs.x - x2 * cs.y); MKR[(size_t)(t0 + k) * 32 + 16 + i] = (bf16)f2bf(x1 * cs.y + x2 * cs.x);
            }
            LDS_WAIT();
        }
    }
    __syncthreads();
    {
        LAS float* kf = (LAS float*)C.lds;
        LAS float* vf = kf + 64 * 65;
        float* RKV = (float*)(ws + WS_RKV);
        for (int it = blockIdx.x; it < NB * 4 * 64; it += C.G) {
            const int j = it & 63, h = (it >> 6) & 3, b = it >> 8;
            const float lg = log1pf(-exp2f(-5.f - (float)h));
            const size_t t0 = (size_t)b * SEQ + 64 * j;
            for (int idx = C.tid; idx < 4096; idx += 512) {
                const int m = idx >> 6, d = idx & 63;
                kf[m * 65 + d] = bf2f(HA[(t0 + m) * NINA + HA_RK + h * 64 + d]) * 0.125f * __expf(lg * (float)(63 - m));
                vf[m * 65 + d] = bf2f(HA[(t0 + m) * NINA + HA_RV + h * 64 + d]);
            }
            __syncthreads();
            for (int idx = C.tid; idx < 4096; idx += 512) {
                const int d = idx >> 6, e = idx & 63; float s = 0.f;
                for (int m = 0; m < 64; ++m) s += kf[m * 65 + d] * vf[m * 65 + e];
                RKV[(size_t)it * 4096 + idx] = s;
            }
            __syncthreads();
        }
    }
    {
        const float2* lam = (const float2*)(ws + WS_S5LAM); const float2* bbar = (const float2*)(ws + WS_S5BBAR);
        float2* E = (float2*)(ws + WS_S5E);
        for (int idx = C.gtid; idx < NB * 64 * 16 * 64; idx += C.NT) {
            const int p = idx & 63, g = (idx >> 6) & 15, j = (idx >> 10) & 63, b = idx >> 16;
            const float2 L = lam[g * 64 + p];
            float2 B[16];
#pragma unroll
            for (int c = 0; c < 16; ++c) B[c] = bbar[(size_t)(g * 64 + p) * 16 + c];
            float xr = 0.f, xi = 0.f;
            const bf16* up = HA + ((size_t)b * SEQ + 64 * j) * NINA + HA_SU + 16 * g;
            for (int s = 0; s < 64; ++s) {
                float u[16]; ld8(up + (size_t)s * NINA, u); ld8(up + (size_t)s * NINA + 8, u + 8);
                float br = 0.f, bi = 0.f;
#pragma unroll
                for (int c = 0; c < 16; ++c) { br += B[c].x * u[c]; bi += B[c].y * u[c]; }
                const float nr = L.x * xr - L.y * xi + br, ni = L.x * xi + L.y * xr + bi; xr = nr; xi = ni;
            }
            E[idx] = make_float2(xr, xi);
        }
    }
}

__device__ __forceinline__ void phase_scans(const Ctx& C, const Args& a) {
    unsigned char* ws = a.ws;
    float* RKV = (float*)(ws + WS_RKV);
    for (int idx = C.gtid; idx < NB * 4 * 4096; idx += C.NT) {
        const int bh = idx >> 12, de = idx & 4095, h = bh & 3;
        const float gch = __expf(64.f * log1pf(-exp2f(-5.f - (float)h)));
        float prev = 0.f;
        for (int j = 0; j < 64; ++j) { float* p = RKV + ((size_t)bh * 64 + j) * 4096 + de; const float kv = *p; *p = prev; prev = gch * prev + kv; }
    }
    const float2* lam64 = (const float2*)(ws + WS_S5LAM64); float2* E = (float2*)(ws + WS_S5E);
    for (int idx = C.gtid; idx < NB * 16 * 64; idx += C.NT) {
        const int gp = idx & 1023, b = idx >> 10; const float2 L = lam64[gp];
        float xr = 0.f, xi = 0.f;
        for (int j = 0; j < 64; ++j) { float2* p = E + ((size_t)(b * 64 + j) * 1024 + gp); const float2 e = *p; *p = make_float2(xr, xi);
            const float nr = L.x * xr - L.y * xi + e.x, ni = L.x * xi + L.y * xr + e.y; xr = nr; xi = ni; }
    }
}

__device__ __forceinline__ void dsa_query_naive(int t, const bf16* HA, bf16* BR, LAS unsigned* keys, LAS float* qf, LAS float* iqf, int lane) {
    const int b = t >> 12, pos = t & (SEQ - 1), limit = ((pos >> 6) + 1) << 6; const size_t rb = (size_t)b * SEQ;
    const bf16* row = HA + (size_t)t * NINA;
    for (int i = lane; i < 256; i += 64) qf[i] = bf2f(row[HA_DQ + i]);
    for (int i = lane; i < 128; i += 64) iqf[i] = bf2f(row[HA_IQ + i]);
    float iw[4];
#pragma unroll
    for (int h = 0; h < 4; ++h) iw[h] = bf2f(row[HA_IW + h]) * 0.08838834764831845f;
    LDS_WAIT();
    for (int j = lane; j < limit; j += 64) {
        const bf16* kr = HA + (rb + j) * NINA + HA_IK; float ik[32];
        ld8(kr, ik); ld8(kr + 8, ik + 8); ld8(kr + 16, ik + 16); ld8(kr + 24, ik + 24);
        float s = 0.f;
#pragma unroll
        for (int h = 0; h < 4; ++h) { float d = 0.f;
#pragma unroll
            for (int c = 0; c < 32; ++c) d += iqf[h * 32 + c] * ik[c];
            s += fmaxf(d, 0.f) * iw[h]; }
        s += 0.f;
        unsigned u = __float_as_uint(s); u = (u & 0x80000000u) ? ~u : (u | 0x80000000u);
        keys[j] = (u & 0xFFFFF000u) | (unsigned)(4095 - j);
    }
    LDS_WAIT();
    unsigned Tst = 0u;
    if (limit > 256) {
        for (int bit = 31; bit >= 0; --bit) {
            const unsigned cand = Tst | (1u << bit); int cnt = 0;
            for (int j = lane; j < limit; j += 64) cnt += keys[j] >= cand ? 1 : 0;
            cnt = wave_sum_i(cnt);
            if (cnt >= 256) Tst = cand;
        }
    }
    for (int h = 0; h < 4; ++h) {
        const float slope = exp2f(-2.f * (float)(h + 1));
        float m = -INFINITY, l = 0.f; float o[64];
#pragma unroll
        for (int d = 0; d < 64; ++d) o[d] = 0.f;
        for (int j = lane; j < limit; j += 64) {
            if (keys[j] >= Tst) {
                const bf16* kp = HA + (rb + j) * NINA + HA_DK; float dot = 0.f;
#pragma unroll
                for (int c8 = 0; c8 < 8; ++c8) { float kv[8]; ld8(kp + c8 * 8, kv);
#pragma unroll
                    for (int i = 0; i < 8; ++i) dot += qf[h * 64 + c8 * 8 + i] * kv[i]; }
                const float logit = dot * 0.125f - slope * fabsf((float)(pos - j));
                const float mn = fmaxf(m, logit), sc = __expf(m - mn), p = __expf(logit - mn);
                l = l * sc + p; m = mn;
                const bf16* vp = HA + (rb + j) * NINA + HA_DV;
#pragma unroll
                for (int c8 = 0; c8 < 8; ++c8) { float vv[8]; ld8(vp + c8 * 8, vv);
#pragma unroll
                    for (int i = 0; i < 8; ++i) o[c8 * 8 + i] = o[c8 * 8 + i] * sc + p * vv[i]; }
            }
        }
        const float M = wave_max(m); const float f = (m == -INFINITY) ? 0.f : __expf(m - M);
        const float L = wave_sum(l * f); float res = 0.f;
#pragma unroll
        for (int d = 0; d < 64; ++d) { const float v = wave_sum(o[d] * f); if (lane == d) res = v; }
        BR[(size_t)t * DM + h * 64 + lane] = (bf16)f2bf(res / L);
    }
}

__device__ __forceinline__ void mla_query_naive(int t, const bf16* MQ, const bf16* MKV, const bf16* MKR, bf16* BR, LAS float* qf, int lane) {
    const int b = t >> 12, pos = t & (SEQ - 1), limit = ((pos >> 6) + 1) << 6; const size_t rb = (size_t)b * SEQ;
    for (int i = lane; i < 384; i += 64) qf[i] = bf2f(MQ[(size_t)t * 384 + i]);
    LDS_WAIT();
    for (int h = 0; h < 4; ++h) {
        float m = -INFINITY, l = 0.f; float o[64];
#pragma unroll
        for (int d = 0; d < 64; ++d) o[d] = 0.f;
        for (int j = lane; j < limit; j += 64) {
            const bf16* kp = MKV + (rb + j) * 512 + h * 128; const bf16* rp = MKR + (rb + j) * 32; float dot = 0.f;
#pragma unroll
            for (int c8 = 0; c8 < 8; ++c8) { float kv[8]; ld8(kp + c8 * 8, kv);
#pragma unroll
                for (int i = 0; i < 8; ++i) dot += qf[h * 96 + c8 * 8 + i] * kv[i]; }
#pragma unroll
            for (int c8 = 0; c8 < 4; ++c8) { float kv[8]; ld8(rp + c8 * 8, kv);
#pragma unroll
                for (int i = 0; i < 8; ++i) dot += qf[h * 96 + 64 + c8 * 8 + i] * kv[i]; }
            const float logit = dot;
            const float mn = fmaxf(m, logit), sc = __expf(m - mn), p = __expf(logit - mn);
            l = l * sc + p; m = mn;
            const bf16* vp = kp + 64;
#pragma unroll
            for (int c8 = 0; c8 < 8; ++c8) { float vv[8]; ld8(vp + c8 * 8, vv);
#pragma unroll
                for (int i = 0; i < 8; ++i) o[c8 * 8 + i] = o[c8 * 8 + i] * sc + p * vv[i]; }
        }
        const float M = wave_max(m); const float f = __expf(m - M);
        const float L = wave_sum(l * f); float res = 0.f;
#pragma unroll
        for (int d = 0; d < 64; ++d) { const float v = wave_sum(o[d] * f); if (lane == d) res = v; }
        BR[(size_t)t * DM + 768 + h * 64 + lane] = (bf16)f2bf(res / L);
    }
}

__device__ __forceinline__ void phase_mixers_naive(const Ctx& C, const Args& a, int l) {
    unsigned char* ws = a.ws;
    const bf16* HA = (const bf16*)(ws + WS_HA); bf16* BR = (bf16*)(ws + WS_BR);
    const int lane = C.lane;
#if NAIVE_DSA
    {
        LAS unsigned* keys = (LAS unsigned*)(C.lds + C.wave * 16384);
        LAS float* qf = (LAS float*)(C.lds + 131072 + C.wave * 1536);
        LAS float* iqf = qf + 256;
        for (int t = C.gw; t < T; t += C.NGW) { dsa_query_naive(t, HA, BR, keys, qf, iqf, lane); LDS_WAIT(); }
    }
#endif
    __syncthreads();
#if NAIVE_MLA
    {
        LAS float* qf = (LAS float*)(C.lds + C.wave * 1536);
        for (int t = C.gw; t < T; t += C.NGW) { mla_query_naive(t, (const bf16*)(ws + WS_MQ), (const bf16*)(ws + WS_MKV), (const bf16*)(ws + WS_MKR), BR, qf, lane); LDS_WAIT(); }
    }
#endif
    __syncthreads();
#if NAIVE_RET
    {
        LAS float* qf = (LAS float*)C.lds; LAS float* kf = qf + 64 * 65; LAS float* vf = kf + 64 * 65; LAS float* sc = vf + 64 * 65; LAS float* rt = sc + 64 * 65;
        LAS float* pv = rt + 64 * 65;
        const float* RKV = (const float*)(ws + WS_RKV); const float* gnw = a.in[6] + l * 256;
        for (int it = blockIdx.x; it < NB * 4 * 64; it += C.G) {
            const int j = it & 63, h = (it >> 6) & 3, b = it >> 8;
            const float lg = log1pf(-exp2f(-5.f - (float)h));
            const size_t t0 = (size_t)b * SEQ + 64 * j;
            for (int idx = C.tid; idx < 4096; idx += 512) {
                const int m = idx >> 6, d = idx & 63; const bf16* row = HA + (t0 + m) * NINA + h * 64 + d;
                qf[m * 65 + d] = bf2f(row[HA_RQ]); kf[m * 65 + d] = bf2f(row[HA_RK]) * 0.125f; vf[m * 65 + d] = bf2f(row[HA_RV]);
                pv[idx] = RKV[(size_t)it * 4096 + idx];
            }
            __syncthreads();
            for (int idx = C.tid; idx < 4096; idx += 512) {
                const int n = idx >> 6, m = idx & 63; float s = 0.f;
                for (int d = 0; d < 64; ++d) s += qf[n * 65 + d] * kf[m * 65 + d];
                sc[n * 65 + m] = s * __expf(lg * fabsf((float)(n - m)));
            }
            __syncthreads();
            for (int idx = C.tid; idx < 4096; idx += 512) {
                const int n = idx >> 6, e = idx & 63; float s = 0.f, s2 = 0.f;
                for (int m = 0; m < 64; ++m) s += sc[n * 65 + m] * vf[m * 65 + e];
                for (int d = 0; d < 64; ++d) s2 += qf[n * 65 + d] * pv[d * 64 + e];
                rt[n * 65 + e] = s + s2 * __expf(lg * (float)(n + 1));
            }
            __syncthreads();
            for (int n = C.wave; n < 64; n += 8) {
                const float v = rt[n * 65 + lane]; const float mean = wave_sum(v) * (1.f / 64.f); const float dv = v - mean;
                const float var = wave_sum(dv * dv) * (1.f / 64.f);
                const float gv = bf2f(HA[(t0 + n) * NINA + HA_RG + h * 64 + lane]);
                BR[(t0 + n) * DM + 256 + h * 64 + lane] = (bf16)f2bf(dv * (1.f / sqrtf(var + LN_EPS)) * gnw[h * 64 + lane] * silu_f(gv));
            }
            __syncthreads();
        }
    }
#endif
#if NAIVE_S5
    {
        LAS float* SY = (LAS float*)C.lds;
        const float2* lam = (const float2*)(ws + WS_S5LAM); const float2* bbar = (const float2*)(ws + WS_S5BBAR); const float2* E = (const float2*)(ws + WS_S5E);
        const float* cre = a.in[11] + (size_t)l * 16 * 16 * 64; const float* cim = a.in[12] + (size_t)l * 16 * 16 * 64; const float* dd = a.in[13] + l * 256;
        const float* wglu = a.in[15] + (size_t)l * 256 * 512;
        for (int it = blockIdx.x; it < NB * 64; it += C.G) {
            const int j = it & 63, b = it >> 6; const size_t t0 = (size_t)b * SEQ + 64 * j;
            for (int r = 0; r < 2; ++r) {
                const int g = r * 8 + C.wave, p = lane;
                const float2 L = lam[g * 64 + p];
                float2 B[16]; float cr[16], ci[16];
#pragma unroll
                for (int c = 0; c < 16; ++c) { B[c] = bbar[(size_t)(g * 64 + p) * 16 + c]; cr[c] = cre[(g * 16 + c) * 64 + p]; ci[c] = cim[(g * 16 + c) * 64 + p]; }
                const float2 x0 = E[(size_t)it * 1024 + g * 64 + p];
                float xr = x0.x, xi = x0.y;
                const float dval = lane < 16 ? dd[g * 16 + lane] : 0.f;
                for (int s = 0; s < 64; ++s) {
                    const bf16* up = HA + (t0 + s) * NINA + HA_SU + 16 * g;
                    float u[16]; ld8(up, u); ld8(up + 8, u + 8);
                    float br = 0.f, bi = 0.f;
#pragma unroll
                    for (int c = 0; c < 16; ++c) { br += B[c].x * u[c]; bi += B[c].y * u[c]; }
                    const float nr = L.x * xr - L.y * xi + br, ni = L.x * xi + L.y * xr + bi; xr = nr; xi = ni;
                    float yv = 0.f, uv = 0.f;
#pragma unroll
                    for (int c = 0; c < 16; ++c) { const float v = wave_sum(xr * cr[c] - xi * ci[c]); if (lane == c) { yv = v; uv = u[c]; } }
                    if (lane < 16) SY[s * 256 + g * 16 + lane] = gelu_tanh(yv + dval * uv);
                }
            }
            __syncthreads();
            {
                const int n = C.tid & 255, half = C.tid >> 8;
                float av[32], ag[32];
#pragma unroll
                for (int k = 0; k < 32; ++k) { av[k] = 0.f; ag[k] = 0.f; }
                for (int kk = 0; kk < 256; ++kk) {
                    const float wv = wglu[(size_t)kk * 512 + n], wg = wglu[(size_t)kk * 512 + 256 + n];
#pragma unroll
                    for (int k = 0; k < 32; ++k) { const float y = SY[(half * 32 + k) * 256 + kk]; av[k] += y * wv; ag[k] += y * wg; }
                }
#pragma unroll
                for (int k = 0; k < 32; ++k) BR[(t0 + half * 32 + k) * DM + 512 + n] = (bf16)f2bf(av[k] * sigm_f(ag[k]));
            }
            __syncthreads();
        }
    }
#endif
}

__device__ __forceinline__ void phase_merge_naive(const Ctx& C, const Args& a, int l) {
    unsigned char* ws = a.ws;
    const bf16* BR = (const bf16*)(ws + WS_BR); const bf16* GT = (const bf16*)(ws + WS_GATES); bf16* MG = (bf16*)(ws + WS_MERGED);
    const float* wb = a.in[20] + (size_t)l * 4 * 256 * DM;
    LAS float* brf = (LAS float*)C.lds;
    for (int it = blockIdx.x; it < T / 16; it += C.G) {
        const int t0 = it * 16;
        for (int idx = C.tid; idx < 16 * 1024; idx += 512) brf[idx] = ((DBG_ZERO_BR >> ((idx & 1023) >> 8)) & 1) ? 0.f : bf2f(BR[(size_t)t0 * DM + idx]);
        __syncthreads();
        for (int dh = 0; dh < 2; ++dh) {
            const int d = C.tid + 512 * dh;
            float tot[16];
#pragma unroll
            for (int k = 0; k < 16; ++k) tot[k] = 0.f;
            for (int n = 0; n < 4; ++n) {
                float acc[16];
#pragma unroll
                for (int k = 0; k < 16; ++k) acc[k] = 0.f;
                for (int c = 0; c < 256; ++c) {
                    const float w = wb[(size_t)(n * 256 + c) * DM + d];
#pragma unroll
                    for (int k = 0; k < 16; ++k) acc[k] += brf[k * 1024 + n * 256 + c] * w;
                }
#pragma unroll
                for (int k = 0; k < 16; ++k) tot[k] += (DBG_GATE_HALF ? 0.5f : (DBG_GATE_RAW ? sigm_f(bf2f(GT[(size_t)(t0 + k) * NGATE + n * 1024 + d])) : bf2f(GT[(size_t)(t0 + k) * NGATE + n * 1024 + d]))) * acc[k];
            }
#pragma unroll
            for (int k = 0; k < 16; ++k) MG[(size_t)(t0 + k) * DM + d] = (bf16)f2bf(tot[k]);
        }
        __syncthreads();
    }
}

constexpr int PH_PER_LAYER = 15, N_PHASES = DEPTH * PH_PER_LAYER;
#ifndef DBG_NPH
#define DBG_NPH N_PHASES
#endif
#ifndef MK_ONE_LAUNCH
#define MK_ONE_LAUNCH 1
#endif
#if MK_ONE_LAUNCH
#define GRID_BAR() xcd_barrier(bar)
#else
#define GRID_BAR() do {} while (0)
#endif

template <int L> __device__ __forceinline__ void layer_phases(const Ctx& C, const Args& args, const int lo, const int hi, const XcdBarrier& bar) {
    unsigned char* ws = args.ws;
    float* X = args.out;
    bf16* XN = (bf16*)(ws + WS_XN);
    constexpr int P0 = L * PH_PER_LAYER;
#define IN(k) (lo <= P0 + (k) && P0 + (k) < hi && !(DBG_SKIP_FFN2 && (k) >= 12) && !(DBG_SKIP_MIXER && (k) >= 4 && (k) <= 11))
#define SEAM(k) do { if (P0 + (k) >= lo && P0 + (k) + 1 < hi) { GRID_BAR(); } } while (0)
    if (IN(0)) { phase_prep(C, args, L); } SEAM(0);
#define FFN_UP(k, f) if (IN(k)) { \
        pg8::Gemm g{(const pg8::bf16_t*)XN, (const pg8::bf16_t*)(ws + WS_WI) + (size_t)(f) * 2 * DFF * DM, T, 2 * DFF, DM}; \
        pg8::StaticOrder S; S.init(T, 2 * DFF, C.G, (int)blockIdx.x); \
        pg8::EpiSwiglu E{(pg8::bf16_t*)(ws + WS_G), DFF}; \
        pg8::gemm_phase<pg8::EpiSwiglu, pg8::StaticOrder, true, true>(C.lds, g, S, E); } SEAM(k);
#define FFN_DOWN(k, f) if (IN(k)) { \
        pg8::Gemm g{(const pg8::bf16_t*)(ws + WS_G), (const pg8::bf16_t*)(ws + WS_WO) + (size_t)(f) * DM * DFF, T, DM, DFF}; \
        pg8::StaticOrder S; S.init(T, DM, C.G, (int)blockIdx.x); \
        pg8::EpiF32 E{(float*)(ws + WS_Z), DM}; \
        pg8::gemm_phase<pg8::EpiF32, pg8::StaticOrder, true, true>(C.lds, g, S, E); } SEAM(k);
    FFN_UP(1, 0)
    FFN_DOWN(2, 0)
    if (IN(3)) { phase_ln(C, (L == 0) ? args.in[0] : X, (const float*)(ws + WS_Z), 0.5f, args.in[1] + (size_t)L * 3 * DM, args.in[2] + (size_t)L * 3 * DM, X, XN); } SEAM(3);
    if (IN(4)) {
        pg8::Gemm g{(const pg8::bf16_t*)XN, (const pg8::bf16_t*)(ws + WS_WIN), T, NINA, DM};
        pg8::StaticOrder S; S.init(T, NINA, C.G, (int)blockIdx.x);
        pg8::EpiStoreBf16<0> E{(pg8::bf16_t*)(ws + WS_HA), NINA};
        pg8::gemm_phase<pg8::EpiStoreBf16<0>, pg8::StaticOrder, true, true>(C.lds, g, S, E);
    } SEAM(4);
    if (IN(5)) { phase_mixprep_naive(C, args, L); } SEAM(5);
    if (IN(6)) { phase_scans(C, args); } SEAM(6);
    if (IN(7)) { phase_mixers_naive(C, args, L); } SEAM(7);
    if (IN(8)) {
        pg8::Gemm g{(const pg8::bf16_t*)XN, (const pg8::bf16_t*)(ws + WS_WG), T, NGATE, DM};
        pg8::StaticOrder S; S.init(T, NGATE, C.G, (int)blockIdx.x);
        pg8::EpiStoreBf16<DBG_GATE_RAW ? 0 : 2> E{(pg8::bf16_t*)(ws + WS_GATES), NGATE};
        pg8::gemm_phase<pg8::EpiStoreBf16<DBG_GATE_RAW ? 0 : 2>, pg8::StaticOrder, true, true>(C.lds, g, S, E);
    } SEAM(8);
    if (IN(9)) { phase_merge_naive(C, args, L); } SEAM(9);
    if (IN(10)) {
        pg8::Gemm g{(const pg8::bf16_t*)(ws + WS_MERGED), (const pg8::bf16_t*)(ws + WS_WOUT), T, DM, DM};
        pg8::StaticOrder S; S.init(T, DM, C.G, (int)blockIdx.x);
        pg8::EpiF32 E{(float*)(ws + WS_Z), DM};
        pg8::gemm_phase<pg8::EpiF32, pg8::StaticOrder, true, true>(C.lds, g, S, E);
    } SEAM(10);
    if (IN(11)) { phase_ln(C, X, (const float*)(ws + WS_Z), 1.0f, args.in[1] + (size_t)(L * 3 + 1) * DM, args.in[2] + (size_t)(L * 3 + 1) * DM, X, XN); } SEAM(11);
    FFN_UP(12, 1)
    FFN_DOWN(13, 1)
    if (IN(14)) { phase_ln(C, X, (const float*)(ws + WS_Z), 0.5f, args.in[1] + (size_t)(L * 3 + 2) * DM, args.in[2] + (size_t)(L * 3 + 2) * DM, X, XN); } SEAM(14);
#undef IN
#undef SEAM
#undef FFN_UP
#undef FFN_DOWN
}

__global__ void __launch_bounds__(NWAVES * 64, 2) mega_fwd(Args args) {
    extern __shared__ __attribute__((aligned(16))) unsigned char lds_raw[];
    Ctx C;
    C.lds = (LAS unsigned char*)lds_raw;
    C.tid = threadIdx.x; C.lane = C.tid & 63; C.wave = __builtin_amdgcn_readfirstlane(C.tid >> 6);
    C.G = gridDim.x; C.gw = blockIdx.x * NWAVES + C.wave; C.NGW = C.G * NWAVES; C.gtid = blockIdx.x * (NWAVES * 64) + C.tid; C.NT = C.G * NWAVES * 64;
    volatile LAS unsigned* MISC = (volatile LAS unsigned*)(C.lds + LDS_BYTES - 128);
    if (C.tid < 32) MISC[C.tid] = 0u;
    __syncthreads();
    XcdBarrier bar; bar.bar = (unsigned*)(args.ws + WS_CTL) + CW_BAR; bar.x = 0; bar.st = nullptr;
#if MK_ONE_LAUNCH
    bar = xcd_barrier_post((unsigned*)(args.ws + WS_CTL) + CW_BAR, MISC + 8);
#endif
    layer_phases<0>(C, args, args.ph_lo, args.ph_hi, bar);
    layer_phases<1>(C, args, args.ph_lo, args.ph_hi, bar);
}

extern "C" void kernel_launch(void* const* d_in, const int* in_sizes, int n_in, void* d_out, int out_size, void* d_ws, size_t ws_size, hipStream_t stream) {
    static int grid = 0;
    if (grid == 0) {
        if (n_in != 22 || out_size != T * DM || ws_size < WS_END) { fprintf(stderr, "kernel_launch: unexpected shapes / workspace (%d inputs, out %d, ws %zu)\n", n_in, out_size, ws_size); grid = -1; return; }
        int dev = 0, cus = 0, per_cu = 0;
        if (hipGetDevice(&dev) != hipSuccess || hipDeviceGetAttribute(&cus, hipDeviceAttributeMultiprocessorCount, dev) != hipSuccess) { grid = -1; return; }
        if (hipFuncSetAttribute((const void*)mega_fwd, hipFuncAttributeMaxDynamicSharedMemorySize, LDS_BYTES) != hipSuccess) { grid = -1; return; }
        if (hipOccupancyMaxActiveBlocksPerMultiprocessor(&per_cu, (const void*)mega_fwd, NWAVES * 64, LDS_BYTES) != hipSuccess || per_cu < 1) { fprintf(stderr, "occupancy query: %d\n", per_cu); }
        (void)hipGetLastError();
        grid = cus;
    }
    if (grid < 0) return;
    (void)hipMemsetAsync((char*)d_ws + WS_CTL, 0, CTL_ZERO_BYTES, stream);
    Args a{};
    for (int i = 0; i < 22; ++i) a.in[i] = (const float*)d_in[i];
    a.out = (float*)d_out; a.ws = (unsigned char*)d_ws;
#if MK_ONE_LAUNCH
    a.ph_lo = 0; a.ph_hi = DBG_NPH;
    void* kargs[] = {&a};
    hipError_t e = hipLaunchCooperativeKernel((const void*)mega_fwd, dim3(grid), dim3(NWAVES * 64), kargs, LDS_BYTES, stream);
    if (e != hipSuccess) fprintf(stderr, "cooperative launch failed: %s (grid %d)\n", hipGetErrorString(e), grid);
#else
    for (int ph = 0; ph < DBG_NPH; ++ph) {
        a.ph_lo = ph; a.ph_hi = ph + 1;
        hipLaunchKernelGGL(mega_fwd, dim3(grid), dim3(NWAVES * 64), LDS_BYTES, stream, a);
    }
#endif
}
```
